# Optimizing an MI355X kernel written in HIP

```python
import math
import jax, jax.numpy as jnp
from jax import lax
import numpy as np

D_MODEL = 1024
BATCH = 4
SEQ = 4096
DEPTH = 4

MIX_WIDTH = D_MODEL
HEAD_DIM = 64
A_WIDTH = D_MODEL // 4
B_WIDTH = D_MODEL // 2
C_WIDTH = D_MODEL // 4
A_HEADS = A_WIDTH // HEAD_DIM
B_HEADS = B_WIDTH // HEAD_DIM
C_GROUPS = C_WIDTH // HEAD_DIM
IN_COLS = 2 * A_WIDTH + 3 * B_WIDTH + 2 * C_WIDTH
CHUNK = 128
MOBA_BLOCK = 256
MOBA_TOPK = 3
Q_BLK = 64
CONV_WIDTH = 31
MEM_LEN = 256
X_HEADS = 4
X_HEAD_DIM = D_MODEL // X_HEADS
D_FF = 4 * D_MODEL
EPS = 1e-6

kernel_name = "hymba_style_gmlp_moba_conformer_hybrid"


def rms_norm(x, g):
    xf = x.astype(jnp.float32)
    y = xf * lax.rsqrt(jnp.mean(xf * xf, axis=-1, keepdims=True) + EPS)
    return (y * g.astype(jnp.float32)).astype(x.dtype)


def layer_norm(x, g, b):
    xf = x.astype(jnp.float32)
    mu = jnp.mean(xf, axis=-1, keepdims=True)
    xc = xf - mu
    var = jnp.mean(xc * xc, axis=-1, keepdims=True)
    y = xc * lax.rsqrt(var + EPS) * g.astype(jnp.float32) + b.astype(jnp.float32)
    return y.astype(x.dtype)


def alibi_slopes(n_heads):
    return 2.0 ** (-8.0 * jnp.arange(1, n_heads + 1, dtype=jnp.float32) / n_heads)


def spatial_gating(z, ln_g, ln_b, w_s, b_s):
    Bn, S, _ = z.shape
    u, v = jnp.split(z, 2, axis=-1)
    v = layer_norm(v, ln_g, ln_b)
    v = v.reshape(Bn, S // CHUNK, CHUNK, A_HEADS, HEAD_DIM)
    causal = jnp.tril(jnp.ones((CHUNK, CHUNK), dtype=w_s.dtype))
    w = (w_s * causal[None]).astype(v.dtype)
    mixed = jnp.einsum('hts,bcshd->bcthd', w, v) + b_s.T.astype(v.dtype)[None, None, :, :, None]
    return u * mixed.reshape(Bn, S, A_WIDTH)


def moba_attention(q, k, v):
    Bn, H, S, Dh = q.shape
    s_pad = -(-S // MOBA_BLOCK) * MOBA_BLOCK
    pad = ((0, 0), (0, 0), (0, s_pad - S), (0, 0))
    q, k, v = jnp.pad(q, pad), jnp.pad(k, pad), jnp.pad(v, pad)
    nb = s_pad // MOBA_BLOCK
    kk = min(MOBA_TOPK, nb)
    n_q = s_pad // Q_BLK
    scale = Dh ** -0.5
    slopes = alibi_slopes(H)
    kb = k.reshape(Bn, H, nb, MOBA_BLOCK, Dh)
    vb = v.reshape(Bn, H, nb, MOBA_BLOCK, Dh)
    kmean = jnp.mean(kb.astype(jnp.float32), axis=3)
    qc = q.reshape(Bn, H, n_q, Q_BLK, Dh).transpose(2, 0, 1, 3, 4)
    bi = jnp.arange(Bn)[:, None, None, None]
    hi = jnp.arange(H)[None, :, None, None]
    offs = jnp.arange(MOBA_BLOCK)

    def one_block(args):
        qi, ci = args
        t = ci * Q_BLK + jnp.arange(Q_BLK)
        own = (ci * Q_BLK) // MOBA_BLOCK
        gate = jnp.einsum('bhqd,bhnd->bhqn', qi.astype(jnp.float32), kmean)
        gate = jnp.where(jnp.arange(nb) < own, gate, -jnp.inf)
        _, idx = lax.top_k(gate, kk)
        valid = idx < own
        ksel = kb[bi, hi, idx]
        vsel = vb[bi, hi, idx]
        s_past = jnp.einsum('bhqd,bhqkld->bhqkl', qi, ksel).astype(jnp.float32) * scale
        kpos = idx[..., None] * MOBA_BLOCK + offs
        dist = (t[None, None, :, None, None] - kpos).astype(jnp.float32)
        s_past = jnp.where(valid[..., None], s_past - slopes[None, :, None, None, None] * dist, -jnp.inf)
        k_own = lax.dynamic_index_in_dim(kb, own, axis=2, keepdims=False)
        v_own = lax.dynamic_index_in_dim(vb, own, axis=2, keepdims=False)
        s_own = jnp.einsum('bhqd,bhld->bhql', qi, k_own).astype(jnp.float32) * scale
        kpos_own = own * MOBA_BLOCK + offs
        dist_own = (t[:, None] - kpos_own[None, :]).astype(jnp.float32)
        s_own = jnp.where((dist_own >= 0)[None, None],
                          s_own - slopes[None, :, None, None] * dist_own[None, None], -jnp.inf)
        s_all = jnp.concatenate([s_past.reshape(Bn, H, Q_BLK, kk * MOBA_BLOCK), s_own], axis=-1)
        p = jax.nn.softmax(s_all, axis=-1).astype(v.dtype)
        p_past = p[..., :kk * MOBA_BLOCK].reshape(Bn, H, Q_BLK, kk, MOBA_BLOCK)
        p_own = p[..., kk * MOBA_BLOCK:]
        return (jnp.einsum('bhqkl,bhqkld->bhqd', p_past, vsel)
                + jnp.einsum('bhql,bhld->bhqd', p_own, v_own))

    out = lax.map(one_block, (qc, jnp.arange(n_q, dtype=jnp.int32)))
    out = out.transpose(1, 0, 3, 2, 4).reshape(Bn, s_pad, H * Dh)
    return out[:, :S]


def conformer_conv(z, w_dw, b_dw, gn_g, gn_b):
    Bn, S, _ = z.shape
    a, g = jnp.split(z, 2, axis=-1)
    y = a * jax.nn.sigmoid(g)
    rhs = w_dw.astype(y.dtype)[:, None, :]
    y = lax.conv_general_dilated(y, rhs, window_strides=(1,), padding=[(CONV_WIDTH - 1, 0)],
                                 dimension_numbers=('NWC', 'WIO', 'NWC'),
                                 feature_group_count=C_WIDTH)
    y = y + b_dw.astype(y.dtype)
    y = y.reshape(Bn, S, C_GROUPS, HEAD_DIM)
    y = layer_norm(y, gn_g.reshape(C_GROUPS, HEAD_DIM), gn_b.reshape(C_GROUPS, HEAD_DIM))
    return jax.nn.silu(y.reshape(Bn, S, C_WIDTH))


def memory_cross_attention(h, m, w_q, w_kv, w_o):
    Bn, S, _ = h.shape
    M = m.shape[1]
    q = (h @ w_q).reshape(Bn, S, X_HEADS, X_HEAD_DIM)
    k, v = jnp.split(m @ w_kv, 2, axis=-1)
    k = k.reshape(Bn, M, X_HEADS, X_HEAD_DIM)
    v = v.reshape(Bn, M, X_HEADS, X_HEAD_DIM)
    s = jnp.einsum('bshd,bmhd->bhsm', q, k).astype(jnp.float32) * (X_HEAD_DIM ** -0.5)
    p = jax.nn.softmax(s, axis=-1).astype(v.dtype)
    o = jnp.einsum('bhsm,bmhd->bshd', p, v).reshape(Bn, S, D_MODEL)
    return o @ w_o


def setup_inputs(seed: int = 0) -> dict:
    key = jax.random.key(seed)
    ks = jax.random.split(key, 24)
    f32 = jnp.float32
    L = DEPTH

    def nrm(k, shape, scale):
        return jax.random.normal(k, shape, f32) * scale

    def gain(k, shape):
        return 1.0 + 0.05 * jax.random.normal(k, shape, f32)

    return {
        "x": nrm(ks[0], (BATCH, SEQ, D_MODEL), 1.0),
        "mem": nrm(ks[1], (BATCH, MEM_LEN, D_MODEL), 1.0),
        "pre_mix_g": gain(ks[2], (L, D_MODEL)),
        "w_in": nrm(ks[3], (L, D_MODEL, IN_COLS), D_MODEL ** -0.5),
        "gate_ln_g": gain(ks[4], (L, A_WIDTH)),
        "gate_ln_b": nrm(ks[5], (L, A_WIDTH), 0.02),
        "w_s": nrm(ks[6], (L, A_HEADS, CHUNK, CHUNK), CHUNK ** -0.5),
        "b_s": nrm(ks[7], (L, A_HEADS, CHUNK), 0.02),
        "w_dw": nrm(ks[8], (L, CONV_WIDTH, C_WIDTH), CONV_WIDTH ** -0.5),
        "b_dw": nrm(ks[9], (L, C_WIDTH), 0.02),
        "conv_gn_g": gain(ks[10], (L, C_WIDTH)),
        "conv_gn_b": nrm(ks[11], (L, C_WIDTH), 0.02),
        "w_out": nrm(ks[12], (L, MIX_WIDTH, D_MODEL), MIX_WIDTH ** -0.5),
        "post_mix_g": gain(ks[13], (L, D_MODEL)),
        "pre_x_g": gain(ks[14], (L, D_MODEL)),
        "mem_g": gain(ks[15], (L, D_MODEL)),
        "w_xq": nrm(ks[16], (L, D_MODEL, D_MODEL), D_MODEL ** -0.5),
        "w_xkv": nrm(ks[17], (L, D_MODEL, 2 * D_MODEL), D_MODEL ** -0.5),
        "w_xo": nrm(ks[18], (L, D_MODEL, D_MODEL), D_MODEL ** -0.5),
        "post_x_g": gain(ks[19], (L, D_MODEL)),
        "pre_ffn_g": gain(ks[20], (L, D_MODEL)),
        "w_ff1": nrm(ks[21], (L, D_MODEL, D_FF), D_MODEL ** -0.5),
        "w_ff2": nrm(ks[22], (L, D_FF, D_MODEL), D_FF ** -0.5),
        "post_ffn_g": gain(ks[23], (L, D_MODEL)),
    }


def reference(x, mem, pre_mix_g, w_in, gate_ln_g, gate_ln_b, w_s, b_s, w_dw, b_dw,
              conv_gn_g, conv_gn_b, w_out, post_mix_g, pre_x_g, mem_g, w_xq, w_xkv,
              w_xo, post_x_g, pre_ffn_g, w_ff1, w_ff2, post_ffn_g):
    Bn, S, _ = x.shape
    split_a = 2 * A_WIDTH
    split_b = split_a + 3 * B_WIDTH
    for l in range(DEPTH):
        h = rms_norm(x, pre_mix_g[l])
        z = h @ w_in[l]
        za, zb, zc = z[..., :split_a], z[..., split_a:split_b], z[..., split_b:]
        ya = spatial_gating(jax.nn.gelu(za, approximate=False),
                            gate_ln_g[l], gate_ln_b[l], w_s[l], b_s[l])
        q, k, v = jnp.split(zb, 3, axis=-1)
        q, k, v = (a.reshape(Bn, S, B_HEADS, HEAD_DIM).transpose(0, 2, 1, 3) for a in (q, k, v))
        yb = moba_attention(q, k, v)
        yc = conformer_conv(zc, w_dw[l], b_dw[l], conv_gn_g[l], conv_gn_b[l])
        y = jnp.concatenate([ya, yb, yc], axis=-1) @ w_out[l]
        x = x + rms_norm(y, post_mix_g[l])
        h = rms_norm(x, pre_x_g[l])
        m = rms_norm(mem, mem_g[l])
        x = x + rms_norm(memory_cross_attention(h, m, w_xq[l], w_xkv[l], w_xo[l]), post_x_g[l])
        h = rms_norm(x, pre_ffn_g[l])
        f = jnp.square(jax.nn.relu(h @ w_ff1[l])) @ w_ff2[l]
        x = x + rms_norm(f, post_ffn_g[l])
    return x
```

```cpp
#include <hip/hip_runtime.h>
#include <cstdio>
#include <cstdint>
#include <cmath>
#include <hip/hip_bf16.h>

constexpr int DM = 1024, BATCH = 4, SEQ = 4096, DEPTH = 4, M = BATCH * SEQ;
constexpr int HD = 64, AW = 256, BW = 512, CW = 256, AH = 4, BH = 8, CG = 4;
constexpr int INC = 2 * AW + 3 * BW + 2 * CW;
constexpr int CHUNK = 128, MBLK = 256, TOPK = 3, CONVW = 31, MEML = 256, XH = 4, XHD = 256, DFF = 4096;
constexpr float EPS = 1e-6f;
constexpr int ZQ = 512, ZK = 1024, ZV = 1536, ZC = 2048;
constexpr float LOG2E = 1.4426950408889634f;
constexpr float C2 = 0.125f * LOG2E;
constexpr float XSC = 0.0625f * LOG2E;

constexpr size_t MiB = 1u << 20;
constexpr size_t WS_CTL = 0, CTL_ZERO_BYTES = 1 * MiB;
constexpr size_t WS_WT_IN = 1 * MiB;
constexpr size_t WS_WT_OUT = 6 * MiB;
constexpr size_t WS_WN_XQ = 8 * MiB;
constexpr size_t WS_WT_XKV = 10 * MiB;
constexpr size_t WS_WT_XO = 14 * MiB;
constexpr size_t WS_WT_FF1 = 16 * MiB;
constexpr size_t WS_WT_FF2 = 24 * MiB;
constexpr size_t WS_MN = 32 * MiB;
constexpr size_t WS_KV = 34 * MiB;
constexpr size_t WS_WQK = 38 * MiB;
constexpr size_t WS_WVO = 46 * MiB;
constexpr size_t WS_KSUM = 54 * MiB;
constexpr size_t WS_XN = 56 * MiB;
constexpr size_t WS_T = 88 * MiB;
constexpr size_t WS_BIG = 152 * MiB;
constexpr size_t WS_Z = WS_BIG, WS_Y = WS_BIG + 80 * MiB, WS_P = WS_BIG, WS_H = WS_BIG;
constexpr size_t WS_END = 280 * MiB;

enum PhaseType { PH_PRO = 0, PH_KV, PH_FOLD, PH_INPROJ, PH_MIXER, PH_OUTPROJ, PH_NORM1, PH_SGEMM, PH_PVOUT, PH_NORM2, PH_FF1, PH_FF2, PH_NORM3, PH_PER_LAYER };
constexpr int NPH = PH_PER_LAYER * DEPTH;

typedef unsigned short bf16;
typedef unsigned v4u __attribute__((ext_vector_type(4)));
typedef unsigned v2u __attribute__((ext_vector_type(2)));
typedef float f32x4 __attribute__((ext_vector_type(4)));
#define LAS __attribute__((address_space(3)))
#define GAS __attribute__((address_space(1)))

__device__ __forceinline__ float bf2f(unsigned u) { return __uint_as_float(u << 16); }
__device__ __forceinline__ unsigned f2bf(float f) { unsigned u = __builtin_bit_cast(unsigned, f); return (u + 0x7fffu + ((u >> 16) & 1u)) >> 16; }
__device__ __forceinline__ unsigned pk2(float lo, float hi) { return f2bf(lo) | (f2bf(hi) << 16); }
__device__ __forceinline__ float wave_sum(float v) {
#pragma unroll
    for (int o = 1; o < 64; o <<= 1) v += __shfl_xor(v, o);
    return v;
}
__device__ __forceinline__ float wave_max(float v) {
#pragma unroll
    for (int o = 1; o < 64; o <<= 1) v = fmaxf(v, __shfl_xor(v, o));
    return v;
}

struct Args { GAS const float* in[24]; GAS float* out; GAS unsigned char* ws; int ph_lo, ph_hi; };
template <class T> __device__ __forceinline__ T* as_global(GAS T* p) { return (T*)p; }
typedef const __attribute__((address_space(4))) Args* KArgs;

__device__ __forceinline__ void transpose_item(const float* W, int K, int N, bf16* WT, LAS float* scr, int item, int lane) {
    const int nblk = N / 32, kb = item / nblk, nb = item % nblk, k0 = 64 * kb, n0 = 32 * nb;
#pragma unroll 8
    for (int i = 0; i < 32; ++i) { const int kk = 2 * i + (lane >> 5); scr[kk * 33 + (lane & 31)] = W[(size_t)(k0 + kk) * N + n0 + (lane & 31)]; }
    asm volatile("s_waitcnt lgkmcnt(0)" ::: "memory");
    const int c = lane & 7;
#pragma unroll
    for (int j = 0; j < 4; ++j) { const int n = (lane >> 3) + 8 * j; const LAS float* s = scr + (8 * c) * 33 + n;
        v4u o; o.x = pk2(s[0 * 33], s[1 * 33]); o.y = pk2(s[2 * 33], s[3 * 33]); o.z = pk2(s[4 * 33], s[5 * 33]); o.w = pk2(s[6 * 33], s[7 * 33]);
        *(v4u*)(WT + (size_t)(n0 + n) * K + k0 + 8 * c) = o; }
    asm volatile("s_waitcnt lgkmcnt(0)" ::: "memory");
}
__device__ __forceinline__ void rms_row_to_bf16(const float* xrow, const float* g, bf16* orow, int lane) {
    const f32x4* xr = (const f32x4*)xrow + lane; const f32x4* gr = (const f32x4*)g + lane;
    f32x4 v[4]; float s = 0.f;
#pragma unroll
    for (int j = 0; j < 4; ++j) { v[j] = xr[64 * j]; s += (v[j].x * v[j].x + v[j].y * v[j].y) + (v[j].z * v[j].z + v[j].w * v[j].w); }
    const float rstd = 1.0f / sqrtf(wave_sum(s) * (1.f / DM) + EPS);
    v2u* o8 = (v2u*)orow + lane;
#pragma unroll
    for (int j = 0; j < 4; ++j) { const f32x4 gg = gr[64 * j]; v2u w; w.x = pk2(v[j].x * rstd * gg.x, v[j].y * rstd * gg.y); w.y = pk2(v[j].z * rstd * gg.z, v[j].w * rstd * gg.w); o8[64 * j] = w; }
}

__device__ __forceinline__ void phase_pro(KArgs ap_, int l, LAS unsigned char* lds, int gw, int NGW, int wave, int lane) {
    unsigned char* ws = as_global(ap_->ws);
    LAS float* scr = (LAS float*)(lds + wave * 16384);
    const float* w_in = as_global(ap_->in[3]) + (size_t)l * DM * INC; const float* w_out = as_global(ap_->in[12]) + (size_t)l * DM * DM;
    const float* w_xq = as_global(ap_->in[16]) + (size_t)l * DM * DM; const float* w_xkv = as_global(ap_->in[17]) + (size_t)l * DM * 2 * DM; const float* w_xo = as_global(ap_->in[18]) + (size_t)l * DM * DM;
    const float* w_ff1 = as_global(ap_->in[21]) + (size_t)l * DM * DFF; const float* w_ff2 = as_global(ap_->in[22]) + (size_t)l * DFF * DM;
    constexpr int I_IN = (DM / 64) * (INC / 32), I_SQ = (DM / 64) * (DM / 32), I_KV = (DM / 64) * (2 * DM / 32), I_F1 = (DM / 64) * (DFF / 32), I_F2 = (DFF / 64) * (DM / 32);
    constexpr int NITEMS = I_IN + I_SQ + I_KV + I_SQ + I_F1 + I_F2;
    for (int it = gw; it < NITEMS; it += NGW) {
        int r = it;
        if (r < I_IN) { transpose_item(w_in, DM, INC, (bf16*)(ws + WS_WT_IN), scr, r, lane); continue; } r -= I_IN;
        if (r < I_SQ) { transpose_item(w_out, DM, DM, (bf16*)(ws + WS_WT_OUT), scr, r, lane); continue; } r -= I_SQ;
        if (r < I_KV) { transpose_item(w_xkv, DM, 2 * DM, (bf16*)(ws + WS_WT_XKV), scr, r, lane); continue; } r -= I_KV;
        if (r < I_SQ) { transpose_item(w_xo, DM, DM, (bf16*)(ws + WS_WT_XO), scr, r, lane); continue; } r -= I_SQ;
        if (r < I_F1) { transpose_item(w_ff1, DM, DFF, (bf16*)(ws + WS_WT_FF1), scr, r, lane); continue; } r -= I_F1;
        transpose_item(w_ff2, DFF, DM, (bf16*)(ws + WS_WT_FF2), scr, r, lane);
    }
    { bf16* wn = (bf16*)(ws + WS_WN_XQ);
      for (int i = gw * 64 + lane; i < DM * DM / 8; i += NGW * 64) { const f32x4 p = ((const f32x4*)w_xq)[2 * i], q = ((const f32x4*)w_xq)[2 * i + 1];
          v4u o; o.x = pk2(p.x, p.y); o.y = pk2(p.z, p.w); o.z = pk2(q.x, q.y); o.w = pk2(q.z, q.w); ((v4u*)wn)[i] = o; } }
    for (int r = gw; r < BATCH * MEML; r += NGW) rms_row_to_bf16(as_global(ap_->in[1]) + (size_t)r * DM, as_global(ap_->in[15]) + (size_t)l * DM, (bf16*)(ws + WS_MN) + (size_t)r * DM, lane);
    if (l == 0) {
        for (int r = gw; r < M; r += NGW) {
            const f32x4* xr = (const f32x4*)(as_global(ap_->in[0]) + (size_t)r * DM) + lane; f32x4* xo = (f32x4*)(as_global(ap_->out) + (size_t)r * DM) + lane;
#pragma unroll
            for (int j = 0; j < 4; ++j) xo[64 * j] = xr[64 * j];
            rms_row_to_bf16(as_global(ap_->in[0]) + (size_t)r * DM, as_global(ap_->in[2]), (bf16*)(ws + WS_XN) + (size_t)r * DM, lane);
        }
    }
}
__device__ __forceinline__ void phase_norm(KArgs ap_, const float* g_post, const float* g_next, int gw, int NGW, int lane) {
    const float* T = (const float*)(as_global(ap_->ws) + WS_T); bf16* XN = (bf16*)(as_global(ap_->ws) + WS_XN);
    for (int r = gw; r < M; r += NGW) {
        const f32x4* tr = (const f32x4*)(T + (size_t)r * DM) + lane; f32x4* xr = (f32x4*)(as_global(ap_->out) + (size_t)r * DM) + lane;
        const f32x4* gp = (const f32x4*)g_post + lane;
        f32x4 t[4], x[4]; float s = 0.f;
#pragma unroll
        for (int j = 0; j < 4; ++j) { t[j] = tr[64 * j]; x[j] = xr[64 * j]; s += (t[j].x * t[j].x + t[j].y * t[j].y) + (t[j].z * t[j].z + t[j].w * t[j].w); }
        const float rstd = 1.0f / sqrtf(wave_sum(s) * (1.f / DM) + EPS); float s2 = 0.f;
#pragma unroll
        for (int j = 0; j < 4; ++j) { const f32x4 g = gp[64 * j]; x[j] = x[j] + t[j] * rstd * g; xr[64 * j] = x[j]; s2 += (x[j].x * x[j].x + x[j].y * x[j].y) + (x[j].z * x[j].z + x[j].w * x[j].w); }
        if (g_next) {
            const float r2 = 1.0f / sqrtf(wave_sum(s2) * (1.f / DM) + EPS); const f32x4* gn = (const f32x4*)g_next + lane; v2u* o8 = (v2u*)(XN + (size_t)r * DM) + lane;
#pragma unroll
            for (int j = 0; j < 4; ++j) { const f32x4 g = gn[64 * j]; v2u w; w.x = pk2(x[j].x * r2 * g.x, x[j].y * r2 * g.y); w.y = pk2(x[j].z * r2 * g.z, x[j].w * r2 * g.w); o8[64 * j] = w; }
        }
    }
}

namespace pg8 {
typedef short bf16x8 __attribute__((ext_vector_type(8)));
constexpr int BM = 256, BK = 64, HALF = 128, HTB = HALF * BK * 2, STAGE_BYTES = 8 * HTB, NXCD = 8, WGM = 8;
constexpr int EPI_SCR = 131072 + 1024;
__host__ __device__ __forceinline__ int lds_byte(int r, int c) { const int st = (r >> 4) * 2 + (c >> 5), rr = r & 15, cc = c & 31, ob = rr * 64 + cc * 2; return st * 1024 + (ob ^ (((ob >> 9) & 1) << 5)); }
__host__ __device__ __forceinline__ void stage_rc(int b, int& R, int& C) { const int st = b / 1024, sb = b % 1024, swz = sb ^ (((sb >> 9) & 1) << 5); R = (st >> 1) * 16 + swz / 64; C = (st & 1) * 32 + (swz % 64) / 2; }
__host__ __device__ __forceinline__ int perm32(int rho) { const int n = rho >> 4, i = rho & 15; return 8 * (i >> 2) + 4 * n + (i & 3); }

struct Unit { int pm, pn, pz; };
struct GemmP {
    const bf16* A; const bf16* Bt; int lda, ldb, K; int nM, nN, nZ, zdiv;
    size_t a_s1, a_s2, b_s1, b_s2; int b_pm_div; size_t b_pm_stride;
    __device__ __forceinline__ const char* a_ptr(const Unit& u) const { return (const char*)(A + (size_t)(u.pz / zdiv) * a_s1 + (size_t)(u.pz % zdiv) * a_s2 + (size_t)u.pm * BM * lda); }
    __device__ __forceinline__ const char* b_ptr(const Unit& u) const { return (const char*)(Bt + (size_t)(u.pz / zdiv) * b_s1 + (size_t)(u.pz % zdiv) * b_s2 + (size_t)(u.pm / b_pm_div) * b_pm_stride + (size_t)u.pn * BM * ldb); }
};
struct Sched {
    int nM, nN, per, total, G, c;
    __device__ __forceinline__ void init(const GemmP& g, int G_, int c_) { nM = g.nM; nN = g.nN; per = nM * nN; total = per * g.nZ; G = G_; c = c_; }
    __device__ __forceinline__ bool next(int i, Unit& u) const {
        const long L = (long)i * G + c; if (L >= total) return false;
        u.pz = (int)(L / per); int wgid = (int)(L % per);
        { const int q = per / NXCD, r = per % NXCD, xcd = wgid % NXCD, off = wgid / NXCD; wgid = (xcd < r ? xcd * (q + 1) : r * (q + 1) + (xcd - r) * q) + off; }
        const int nig = WGM * nN, gid = wgid / nig, fm = gid * WGM, gsz = (nM - fm) < WGM ? (nM - fm) : WGM;
        u.pm = fm + ((wgid % nig) % gsz); u.pn = (wgid % nig) / gsz; return true;
    }
};
__device__ __forceinline__ unsigned cvt_pk_bf16(float lo, float hi) { unsigned r; asm volatile("v_cvt_pk_bf16_f32 %0, %1, %2" : "=v"(r) : "v"(lo), "v"(hi)); return r; }
typedef float f32x2 __attribute__((ext_vector_type(2)));
__device__ __forceinline__ f32x2 gelu_pk(f32x2 v) {
    const f32x2 av = __builtin_elementwise_abs(v), d = av * 0.2316418882f + 1.0f;
    f32x2 t; t.x = __builtin_amdgcn_rcpf(d.x); t.y = __builtin_amdgcn_rcpf(d.y);
    f32x2 q = t * 0.5307027145f + (-0.7265760135f); q = q * t + 0.7107068705f; q = q * t + (-0.142248368f); q = q * t + 0.127414796f; q = q * t;
    const f32x2 s = (v * v) * (-0.72134752044f);
    f32x2 e; e.x = __builtin_amdgcn_exp2f(s.x); e.y = __builtin_amdgcn_exp2f(s.y);
    const f32x2 m = v * (q * e), r = v - m;
    f32x2 o; o.x = v.x < 0.f ? m.x : r.x; o.y = v.y < 0.f ? m.y : r.y; return o;
}
enum EpiMode { EM_F32 = 0, EM_BF16, EM_INPROJ, EM_RELU2, EM_SOFTMAX };
template <int MODE> struct Epi {
    static constexpr bool PERM = (MODE != EM_F32);
    void* C; int ldc; float scale; int zdiv; size_t c_s1, c_s2; float* ksum;
    __device__ __forceinline__ void operator()(f32x4 (&acc)[2][2][4][2], const Unit& u, int wr, int wc, int fr, int fq, LAS unsigned char* lds) const {
        const size_t zoff = (size_t)(u.pz / zdiv) * c_s1 + (size_t)(u.pz % zdiv) * c_s2;
        const int row0 = u.pm * BM + wr * 64 + fr;
        if constexpr (MODE == EM_F32) {
            float* Cf = (float*)C + zoff; const int col0 = u.pn * BM + wc * 32 + 4 * fq;
#pragma unroll
            for (int ai = 0; ai < 2; ++ai)
#pragma unroll
                for (int m = 0; m < 4; ++m) { float* rowp = Cf + (size_t)(row0 + ai * HALF + m * 16) * ldc + col0;
#pragma unroll
                    for (int bj = 0; bj < 2; ++bj)
#pragma unroll
                        for (int n = 0; n < 2; ++n) *(f32x4*)(rowp + bj * HALF + n * 16) = acc[ai][bj][m][n]; }
        } else {
            bf16* Cb = (bf16*)C + zoff; const int col0 = u.pn * BM + wc * 32 + 8 * fq;
            if constexpr (MODE == EM_SOFTMAX) {
                LAS float* PX = (LAS float*)(lds + EPI_SCR); LAS float* PS = PX + 1024;
#pragma unroll
                for (int ai = 0; ai < 2; ++ai)
#pragma unroll
                    for (int m = 0; m < 4; ++m) { float v = -INFINITY;
#pragma unroll
                        for (int bj = 0; bj < 2; ++bj)
#pragma unroll
                            for (int n = 0; n < 2; ++n) { const f32x4 x = acc[ai][bj][m][n]; v = fmaxf(v, fmaxf(fmaxf(x[0], x[1]), fmaxf(x[2], x[3]))); }
                        v = fmaxf(v, __shfl_xor(v, 16)); v = fmaxf(v, __shfl_xor(v, 32));
                        if (fq == 0) PX[(ai * HALF + wr * 64 + m * 16 + fr) * 4 + wc] = v; }
                asm volatile("s_waitcnt lgkmcnt(0)" ::: "memory"); __builtin_amdgcn_s_barrier(); asm volatile("" ::: "memory");
#pragma unroll
                for (int ai = 0; ai < 2; ++ai)
#pragma unroll
                    for (int m = 0; m < 4; ++m) { const int r = ai * HALF + wr * 64 + m * 16 + fr; const f32x4 q = *(const LAS f32x4*)(PX + r * 4);
                        const float gm = fmaxf(fmaxf(q[0], q[1]), fmaxf(q[2], q[3])); float s = 0.f;
#pragma unroll
                        for (int bj = 0; bj < 2; ++bj)
#pragma unroll
                            for (int n = 0; n < 2; ++n) { f32x4 x = acc[ai][bj][m][n];
                                x[0] = __builtin_amdgcn_exp2f(x[0] - gm); x[1] = __builtin_amdgcn_exp2f(x[1] - gm); x[2] = __builtin_amdgcn_exp2f(x[2] - gm); x[3] = __builtin_amdgcn_exp2f(x[3] - gm);
                                s += (x[0] + x[1]) + (x[2] + x[3]); acc[ai][bj][m][n] = x; }
                        s += __shfl_xor(s, 16); s += __shfl_xor(s, 32);
                        if (fq == 0) PS[r * 4 + wc] = s; }
                asm volatile("s_waitcnt lgkmcnt(0)" ::: "memory"); __builtin_amdgcn_s_barrier(); asm volatile("" ::: "memory");
#pragma unroll
                for (int ai = 0; ai < 2; ++ai)
#pragma unroll
                    for (int m = 0; m < 4; ++m) { const int r = ai * HALF + wr * 64 + m * 16 + fr; const f32x4 q = *(const LAS f32x4*)(PS + r * 4);
                        const float inv = 1.0f / ((q[0] + q[1]) + (q[2] + q[3])); bf16* rowp = Cb + (size_t)(u.pm * BM + r) * ldc + col0;
#pragma unroll
                        for (int bj = 0; bj < 2; ++bj) { const f32x4 v0 = acc[ai][bj][m][0] * inv, v1 = acc[ai][bj][m][1] * inv;
                            v4u w; w.x = cvt_pk_bf16(v0[0], v0[1]); w.y = cvt_pk_bf16(v0[2], v0[3]); w.z = cvt_pk_bf16(v1[0], v1[1]); w.w = cvt_pk_bf16(v1[2], v1[3]);
                            *(v4u*)(rowp + bj * HALF) = w; } }
            } else {
                int act = 0; float sc = scale;
                if constexpr (MODE == EM_RELU2) act = 2;
                if constexpr (MODE == EM_INPROJ) { if (u.pn < 2) act = 1; else if (u.pn < 4) sc = C2;
                    if (u.pn == 4 || u.pn == 5) {
                        f32x4 cs[2][2];
#pragma unroll
                        for (int bj = 0; bj < 2; ++bj)
#pragma unroll
                            for (int n = 0; n < 2; ++n) { f32x4 t = acc[0][bj][0][n];
#pragma unroll
                                for (int m = 1; m < 4; ++m) t += acc[0][bj][m][n];
#pragma unroll
                                for (int m = 0; m < 4; ++m) t += acc[1][bj][m][n];
#pragma unroll
                                for (int o = 1; o < 16; o <<= 1) { t[0] += __shfl_xor(t[0], o); t[1] += __shfl_xor(t[1], o); t[2] += __shfl_xor(t[2], o); t[3] += __shfl_xor(t[3], o); }
                                cs[bj][n] = t; }
                        if (fr == 0) { float* kp = ksum + ((size_t)wr * 64 + u.pm) * 512 + (u.pn - 4) * BM + wc * 32 + 8 * fq;
#pragma unroll
                            for (int bj = 0; bj < 2; ++bj)
#pragma unroll
                                for (int n = 0; n < 2; ++n) *(f32x4*)(kp + bj * HALF + 4 * n) = cs[bj][n]; }
                    } }
#pragma unroll
                for (int ai = 0; ai < 2; ++ai)
#pragma unroll
                    for (int m = 0; m < 4; ++m) { bf16* rowp = Cb + (size_t)(row0 + ai * HALF + m * 16) * ldc + col0;
#pragma unroll
                        for (int bj = 0; bj < 2; ++bj) { f32x4 v0 = acc[ai][bj][m][0], v1 = acc[ai][bj][m][1];
                            if (act == 1) { f32x2 a = gelu_pk((f32x2){v0[0], v0[1]}), b = gelu_pk((f32x2){v0[2], v0[3]}), c = gelu_pk((f32x2){v1[0], v1[1]}), d = gelu_pk((f32x2){v1[2], v1[3]});
                                v0 = (f32x4){a.x, a.y, b.x, b.y}; v1 = (f32x4){c.x, c.y, d.x, d.y}; }
                            else if (act == 2) {
#pragma unroll
                                for (int e = 0; e < 4; ++e) { const float p = fmaxf(v0[e], 0.f), q = fmaxf(v1[e], 0.f); v0[e] = p * p; v1[e] = q * q; } }
                            v0 = v0 * sc; v1 = v1 * sc; v4u w; w.x = cvt_pk_bf16(v0[0], v0[1]); w.y = cvt_pk_bf16(v0[2], v0[3]); w.z = cvt_pk_bf16(v1[0], v1[1]); w.w = cvt_pk_bf16(v1[2], v1[3]);
                            *(v4u*)(rowp + bj * HALF) = w; } }
            }
        }
    }
};

template <class EpiT>
__device__ __forceinline__ void gemm_phase(int tid, LAS unsigned char* lds, const GemmP g, const Sched& S, const EpiT& E) {
    const int wid = __builtin_amdgcn_readfirstlane(tid >> 6), lane = tid & 63, wr = wid >> 2, wc = wid & 3, fr = lane & 15, fq = lane >> 4;
    const int K = g.K, nt = K / BK;
    unsigned voffA[2], voffB[2];
#pragma unroll
    for (int i = 0; i < 2; ++i) { int R, C; stage_rc(tid * 16 + i * 8192, R, C); const int Rb = EpiT::PERM ? ((R & ~31) + perm32(R & 31)) : R;
        voffA[i] = (unsigned)(R * g.lda + C) * 2u; voffB[i] = (unsigned)(Rb * g.ldb + C) * 2u; }
    const size_t kstep = (size_t)(BK * 2);
    const size_t hstepA = (size_t)HALF * g.lda * 2, hstepB = (size_t)HALF * g.ldb * 2;
    const unsigned ldsw = (unsigned)wid * 1024u;
    const int aoff = lds_byte(wr * 64 + fr, fq * 8), boff = lds_byte(wc * 32 + fr, fq * 8);
#define PG8_SA(b, h) (((b) * 2 + (h)) * HTB)
#define PG8_SB(b, h) ((4 + (b) * 2 + (h)) * HTB)
#define PG8_STAGE(bufoff, gbase, voff) do { _Pragma("unroll") for (int _i = 0; _i < 2; ++_i) \
        __builtin_amdgcn_global_load_lds((const unsigned*)((const char*)(gbase) + (voff)[_i]), (LAS unsigned*)(lds + (bufoff) + ldsw + _i * 8192), 16, 0, 0); } while (0)
#define PG8_LDA(dst, b, h) do { _Pragma("unroll") for (int m = 0; m < 4; ++m) _Pragma("unroll") for (int k = 0; k < 2; ++k) dst[m][k] = *(const LAS bf16x8*)(lds + PG8_SA(b, h) + aoff + m * 2048 + k * 1024); } while (0)
#define PG8_LDB(dst, b, h) do { _Pragma("unroll") for (int n = 0; n < 2; ++n) _Pragma("unroll") for (int k = 0; k < 2; ++k) dst[n][k] = *(const LAS bf16x8*)(lds + PG8_SB(b, h) + boff + n * 2048 + k * 1024); } while (0)
#define PG8_MMA(ai, bj, At, Bt) do { __builtin_amdgcn_s_setprio(1); _Pragma("unroll") for (int m = 0; m < 4; ++m) _Pragma("unroll") for (int n = 0; n < 2; ++n) _Pragma("unroll") for (int k = 0; k < 2; ++k) \
        acc[ai][bj][m][n] = __builtin_amdgcn_mfma_f32_16x16x32_bf16(Bt[n][k], At[m][k], acc[ai][bj][m][n], 0, 0, 0); __builtin_amdgcn_s_setprio(0); } while (0)
#define PG8_WAIT_V(n) asm volatile("s_waitcnt vmcnt(" #n ")" ::: "memory")
#define PG8_WAIT_L(n) asm volatile("s_waitcnt lgkmcnt(" #n ")" ::: "memory")
#define PG8_BAR __builtin_amdgcn_s_barrier()
#define PG8_SCHED __builtin_amdgcn_sched_barrier(0)
    LAS unsigned* utab = (LAS unsigned*)(lds + EPI_SCR + 8192);
    int nunits = 0;
    { Unit u; if (tid < 32) { if (S.next(tid, u)) { const unsigned long long pa = (unsigned long long)g.a_ptr(u), pb = (unsigned long long)g.b_ptr(u);
            *(LAS v4u*)(utab + tid * 8) = (v4u){(unsigned)pa, (unsigned)(pa >> 32), (unsigned)pb, (unsigned)(pb >> 32)}; *(LAS v4u*)(utab + tid * 8 + 4) = (v4u){(unsigned)u.pm, (unsigned)u.pn, (unsigned)u.pz, 0u}; } }
      nunits = (S.total - S.c + S.G - 1) / S.G; if (nunits > 32) nunits = 32; if (S.c >= S.total) nunits = 0; }
    asm volatile("s_waitcnt lgkmcnt(0)" ::: "memory"); __builtin_amdgcn_s_barrier(); asm volatile("" ::: "memory");
    if (nunits == 0) return;
#define PG8_RDUNIT(idx, U, PA, PB) do { const v4u _p = *(const LAS v4u*)(utab + (idx) * 8), _q = *(const LAS v4u*)(utab + (idx) * 8 + 4); \
        PA = (const char*)(((unsigned long long)(unsigned)__builtin_amdgcn_readfirstlane(_p.y) << 32) | (unsigned)__builtin_amdgcn_readfirstlane(_p.x)); \
        PB = (const char*)(((unsigned long long)(unsigned)__builtin_amdgcn_readfirstlane(_p.w) << 32) | (unsigned)__builtin_amdgcn_readfirstlane(_p.z)); \
        U.pm = __builtin_amdgcn_readfirstlane(_q.x); U.pn = __builtin_amdgcn_readfirstlane(_q.y); U.pz = __builtin_amdgcn_readfirstlane(_q.z); } while (0)
    Unit cur, nxt; int ui = 0;
    const char* cA; const char* cB;
    PG8_RDUNIT(0, cur, cA, cB);
    f32x4 acc[2][2][4][2];
#pragma unroll
    for (int a = 0; a < 2; ++a)
#pragma unroll
        for (int b = 0; b < 2; ++b)
#pragma unroll
            for (int m = 0; m < 4; ++m)
#pragma unroll
                for (int n = 0; n < 2; ++n) acc[a][b][m][n] = (f32x4){0.f, 0.f, 0.f, 0.f};
    bf16x8 At[4][2], B0[2][2], B1[2][2];
    PG8_STAGE(PG8_SB(0, 0), cB, voffB); PG8_STAGE(PG8_SB(0, 1), cB + hstepB, voffB); PG8_STAGE(PG8_SA(0, 0), cA, voffA); PG8_STAGE(PG8_SA(0, 1), cA + hstepA, voffA);
    if (wr == 1) PG8_BAR;
    PG8_WAIT_V(2); PG8_BAR;
    PG8_STAGE(PG8_SB(1, 0), cB + kstep, voffB); PG8_STAGE(PG8_SA(1, 0), cA + kstep, voffA); PG8_STAGE(PG8_SB(1, 1), cB + hstepB + kstep, voffB);
    PG8_WAIT_V(6); PG8_BAR;
    for (;;) {
        const bool has_next = (ui + 1 < nunits);
        const char* nA = cA; const char* nB = cB; nxt = cur;
        if (has_next) PG8_RDUNIT(ui + 1, nxt, nA, nB);
        for (int t = 0; t < nt; t += 2) {
            const bool last = (t == nt - 2);
            const char* a1 = cA + (size_t)(t + 1) * kstep;
            const char* a2 = last ? nA : cA + (size_t)(t + 2) * kstep; const char* b2 = last ? nB : cB + (size_t)(t + 2) * kstep;
            const char* a3 = a2 + kstep; const char* b3 = b2 + kstep;
            PG8_LDB(B0, 0, 0); PG8_LDB(B1, 0, 1); PG8_SCHED; PG8_LDA(At, 0, 0); PG8_STAGE(PG8_SA(1, 1), a1 + hstepA, voffA);
            PG8_WAIT_V(8); PG8_WAIT_L(0); PG8_BAR; PG8_MMA(0, 0, At, B0); PG8_MMA(0, 1, At, B1); PG8_BAR; PG8_SCHED;
            PG8_LDA(At, 0, 1); PG8_STAGE(PG8_SB(0, 0), b2, voffB); PG8_STAGE(PG8_SB(0, 1), b2 + hstepB, voffB); PG8_STAGE(PG8_SA(0, 0), a2, voffA);
            PG8_WAIT_V(8); PG8_WAIT_L(0); PG8_BAR; PG8_MMA(1, 0, At, B0); PG8_MMA(1, 1, At, B1); PG8_BAR; PG8_SCHED;
            PG8_LDB(B0, 1, 0); PG8_LDB(B1, 1, 1); PG8_SCHED; PG8_LDA(At, 1, 0); PG8_STAGE(PG8_SA(0, 1), a2 + hstepA, voffA);
            PG8_WAIT_V(8); PG8_WAIT_L(0); PG8_BAR; PG8_MMA(0, 0, At, B0); PG8_MMA(0, 1, At, B1); PG8_BAR; PG8_SCHED;
            PG8_LDA(At, 1, 1); PG8_STAGE(PG8_SB(1, 0), b3, voffB); PG8_STAGE(PG8_SB(1, 1), b3 + hstepB, voffB); PG8_STAGE(PG8_SA(1, 0), a3, voffA);
            PG8_WAIT_V(8); PG8_WAIT_L(0); PG8_BAR; PG8_MMA(1, 0, At, B0); PG8_MMA(1, 1, At, B1); PG8_BAR; PG8_SCHED;
        }
        if (wr == 0) PG8_BAR;
        E(acc, cur, wr, wc, fr, fq, lds);
        if (!has_next) break;
#pragma unroll
        for (int a = 0; a < 2; ++a)
#pragma unroll
            for (int b = 0; b < 2; ++b)
#pragma unroll
                for (int m = 0; m < 4; ++m)
#pragma unroll
                    for (int n = 0; n < 2; ++n) acc[a][b][m][n] = (f32x4){0.f, 0.f, 0.f, 0.f};
        cur = nxt; cA = nA; cB = nB; ++ui;
        if (wr == 1) PG8_BAR;
    }
    PG8_WAIT_V(0);
    PG8_BAR;
#undef PG8_RDUNIT
#undef PG8_SA
#undef PG8_SB
#undef PG8_STAGE
#undef PG8_LDA
#undef PG8_LDB
#undef PG8_MMA
#undef PG8_WAIT_V
#undef PG8_WAIT_L
#undef PG8_BAR
#undef PG8_SCHED
}
}


namespace mix {
typedef short bf16x8 __attribute__((ext_vector_type(8)));
typedef float f32x16 __attribute__((ext_vector_type(16)));
__device__ __forceinline__ float sigmoidf_fast(float x) { return __builtin_amdgcn_rcpf(1.0f + __builtin_amdgcn_exp2f(-x * LOG2E)); }
__device__ __forceinline__ void conv_unit(int tid, int unit, const bf16* Z, const float* w_dw, const float* b_dw, const float* gg, const float* gb, bf16* Y, LAS unsigned char* lds) {
    const int b = unit >> 6, t0 = (unit & 63) * 64;
    LAS float* ys = (LAS float*)lds;
    for (int i = tid; i < 94 * 32; i += 512) { const int rr = i >> 5, c8 = (i & 31) * 8; const int t = t0 - 30 + rr;
        f32x4 o0 = (f32x4){0.f, 0.f, 0.f, 0.f}, o1 = o0;
        if (t >= 0) { const bf16* zr = Z + ((size_t)b * SEQ + t) * INC + ZC + c8; const v4u a = *(const v4u*)zr, g = *(const v4u*)(zr + CW);
#pragma unroll
            for (int j = 0; j < 4; ++j) { const unsigned aw = a[j], gw_ = g[j]; const float a0 = bf2f(aw & 0xffffu), a1 = bf2f(aw >> 16), g0 = bf2f(gw_ & 0xffffu), g1 = bf2f(gw_ >> 16);
                const float y0 = a0 * sigmoidf_fast(g0), y1 = a1 * sigmoidf_fast(g1);
                if (j < 2) { o0[2 * j] = y0; o0[2 * j + 1] = y1; } else { o1[2 * j - 4] = y0; o1[2 * j - 3] = y1; } } }
        *(LAS f32x4*)(ys + rr * 256 + c8) = o0; *(LAS f32x4*)(ys + rr * 256 + c8 + 4) = o1; }
    asm volatile("s_waitcnt lgkmcnt(0)" ::: "memory"); __builtin_amdgcn_s_barrier(); asm volatile("" ::: "memory");
    const int c = tid & 255, half = tid >> 8;
    float wt[CONVW];
#pragma unroll
    for (int w = 0; w < CONVW; ++w) wt[w] = w_dw[w * CW + c];
    float yv[62];
#pragma unroll
    for (int i = 0; i < 62; ++i) yv[i] = ys[(32 * half + i) * 256 + c];
    const float bias = b_dw[c], g = gg[c], bb = gb[c];
    bf16* yo = Y + ((size_t)b * SEQ + t0 + 32 * half) * DM + AW + BW + c;
#pragma unroll
    for (int p = 0; p < 32; ++p) { float acc = bias;
#pragma unroll
        for (int w = 0; w < CONVW; ++w) acc += wt[w] * yv[p + w];
        const float mu = wave_sum(acc) * (1.f / HD); const float d = acc - mu; const float rstd = 1.0f / sqrtf(wave_sum(d * d) * (1.f / HD) + EPS);
        const float y = d * rstd * g + bb;
        yo[(size_t)p * DM] = (bf16)f2bf(y * sigmoidf_fast(y)); }
    asm volatile("s_waitcnt lgkmcnt(0)" ::: "memory"); __builtin_amdgcn_s_barrier(); asm volatile("" ::: "memory");
}
__device__ __forceinline__ void gmlp_unit(int tid, int unit, const bf16* Z, const float* ln_g, const float* ln_b, const float* w_s, const float* b_s, bf16* Y, LAS unsigned char* lds) {
    const int lane = tid & 63, wave = __builtin_amdgcn_readfirstlane(tid >> 6);
    const size_t row0 = (size_t)unit * CHUNK;
    LAS unsigned short* Vt = (LAS unsigned short*)lds;
    { float gk[4], bk[4];
#pragma unroll
      for (int k = 0; k < 4; ++k) { gk[k] = ln_g[lane + 64 * k]; bk[k] = ln_b[lane + 64 * k]; }
      for (int i = 0; i < 16; ++i) { const int s = wave * 16 + i; const bf16* zr = Z + (row0 + s) * INC + AW + lane; float x[4]; float sm = 0.f;
#pragma unroll
        for (int k = 0; k < 4; ++k) { x[k] = bf2f(zr[64 * k]); sm += x[k]; }
        const float mu = wave_sum(sm) * (1.f / AW); float q = 0.f;
#pragma unroll
        for (int k = 0; k < 4; ++k) { x[k] -= mu; q += x[k] * x[k]; }
        const float rstd = 1.0f / sqrtf(wave_sum(q) * (1.f / AW) + EPS);
#pragma unroll
        for (int k = 0; k < 4; ++k) Vt[(lane + 64 * k) * 132 + s] = (unsigned short)f2bf(x[k] * rstd * gk[k] + bk[k]); } }
    asm volatile("s_waitcnt lgkmcnt(0)" ::: "memory"); __builtin_amdgcn_s_barrier(); asm volatile("" ::: "memory");
    const int h = wave >> 1, th = wave & 1, r32 = lane & 31, hi = lane >> 5;
    for (int tt = 0; tt < 2; ++tt) { const int t0 = th * 64 + tt * 32; const int nk = (t0 + 32) / 16;
        f32x16 acc0 = {}, acc1 = {};
        for (int ks = 0; ks < nk; ++ks) { const int s0 = 16 * ks + 8 * hi; const float* wp = w_s + ((size_t)(h * CHUNK + t0 + r32)) * CHUNK + s0;
            const f32x4 w0 = *(const f32x4*)wp, w1 = *(const f32x4*)(wp + 4); const int tq = t0 + r32; float wv[8];
#pragma unroll
            for (int j = 0; j < 4; ++j) { wv[j] = (s0 + j <= tq) ? w0[j] : 0.f; wv[4 + j] = (s0 + 4 + j <= tq) ? w1[j] : 0.f; }
            v4u ap; ap.x = pk2(wv[0], wv[1]); ap.y = pk2(wv[2], wv[3]); ap.z = pk2(wv[4], wv[5]); ap.w = pk2(wv[6], wv[7]);
            const bf16x8 a = __builtin_bit_cast(bf16x8, ap);
            const LAS unsigned short* vb = Vt + (h * HD + r32) * 132 + s0;
            v4u b0p, b1p; { const v2u lo = *(const LAS v2u*)vb, hi2 = *(const LAS v2u*)(vb + 4); b0p = (v4u){lo.x, lo.y, hi2.x, hi2.y}; }
            { const v2u lo = *(const LAS v2u*)(vb + 32 * 132), hi2 = *(const LAS v2u*)(vb + 32 * 132 + 4); b1p = (v4u){lo.x, lo.y, hi2.x, hi2.y}; }
            acc0 = __builtin_amdgcn_mfma_f32_32x32x16_bf16(a, __builtin_bit_cast(bf16x8, b0p), acc0, 0, 0, 0);
            acc1 = __builtin_amdgcn_mfma_f32_32x32x16_bf16(a, __builtin_bit_cast(bf16x8, b1p), acc1, 0, 0, 0); }
#pragma unroll
        for (int r = 0; r < 16; ++r) { const int t = t0 + (r & 3) + 8 * (r >> 2) + 4 * hi; const float bs = b_s[h * CHUNK + t];
            const size_t zi = (row0 + t) * INC + h * HD + r32, yi = (row0 + t) * DM + h * HD + r32;
            Y[yi] = (bf16)f2bf(bf2f(Z[zi]) * (acc0[r] + bs)); Y[yi + 32] = (bf16)f2bf(bf2f(Z[zi + 32]) * (acc1[r] + bs)); } }
    asm volatile("s_waitcnt lgkmcnt(0)" ::: "memory"); __builtin_amdgcn_s_barrier(); asm volatile("" ::: "memory");
}
}

namespace moba {
using bf16=__hip_bfloat16;
using bf16x8=__attribute__((ext_vector_type(8)))short;
using s16x4=__attribute__((ext_vector_type(4)))short;
using f32x16=__attribute__((ext_vector_type(16)))float;
using u32x4=__attribute__((ext_vector_type(4)))unsigned;
using f32x4_t=__attribute__((ext_vector_type(4)))float;
constexpr int NHEAD=8,SEQ=4096,D=64,ZP=2560,YP=1024;
constexpr int NW=8,QBLK=32,QB=QBLK*NW,KVBLK=64,NQB=SEQ/QB;
__device__ __forceinline__ int crow(int r,int hi){return (r&3)+8*(r>>2)+4*hi;}
#define SBAR() __builtin_amdgcn_sched_barrier(0)
__device__ __forceinline__ void cmask(f32x16&p0,f32x16&p1,int jb,int qrel,int hi){
  const float NEG=-INFINITY; int kb=64*jb+4*hi;
  #pragma unroll
  for(int r=0;r<16;++r){int kv=kb+(r&3)+8*(r>>2); if(kv>qrel)p0[r]=NEG; if(kv+32>qrel)p1[r]=NEG;}
}

constexpr int NSLOT=3, SLOTB=8192;
constexpr int LDS_K=0, LDS_V=NSLOT*SLOTB, LDS_WS=2*NSLOT*SLOTB, LDS_OST=LDS_WS+NW*64*4, LDS_BYTES=LDS_OST+NW*4096;
__device__ __forceinline__ void glds16(const void*gsrc,unsigned lds_dst){unsigned keep;
  asm volatile("s_mov_b32 %0, m0\n\ts_mov_b32 m0, %2\n\ts_nop 0\n\tglobal_load_lds_dwordx4 %1, off\n\ts_mov_b32 m0, %0":"=&s"(keep):"v"(gsrc),"s"(lds_dst):"memory");}
__device__ __forceinline__ float max3f(float a,float b,float c){float r;asm("v_max3_f32 %0, %1, %2, %3":"=v"(r):"v"(a),"v"(b),"v"(c));return r;}
__device__ __forceinline__ float max2f(float a,float b){float r;asm("v_max_f32_e32 %0, %1, %2":"=v"(r):"v"(a),"v"(b));return r;}
__device__ __forceinline__ float fadd_s(float a,float b){float r;asm("v_add_f32_e32 %0, %1, %2":"=v"(r):"v"(a),"v"(b));return r;}
__device__ __forceinline__ float fsub_s(float a,float b){float r;asm("v_sub_f32_e32 %0, %1, %2":"=v"(r):"v"(a),"v"(b));return r;}
typedef float f32x2_t __attribute__((ext_vector_type(2))); typedef __bf16 bf16x2_t __attribute__((ext_vector_type(2)));
__device__ __forceinline__ unsigned cvtpk_s(float lo,float hi){f32x2_t v={lo,hi};bf16x2_t b=__builtin_convertvector(v,bf16x2_t);return __builtin_bit_cast(unsigned,b);}
#define WAIT_BAR(N) asm volatile("s_waitcnt vmcnt(" #N ") lgkmcnt(0)\n\ts_barrier":::"memory")

__device__ __forceinline__ void qkt(f32x16&p0,f32x16&p1,const char*Kslot,const bf16x8*qr,int r32,int hi){
  const char*kb=Kslot+hi*1024+r32*16;
  #pragma unroll
  for(int d0=0;d0<4;++d0){
    const bf16x8 b0=*reinterpret_cast<const bf16x8*>(kb+d0*2048);
    const bf16x8 b1=*reinterpret_cast<const bf16x8*>(kb+d0*2048+512);
    p0=__builtin_amdgcn_mfma_f32_32x32x16_bf16(b0,qr[d0],p0,0,0,0);p1=__builtin_amdgcn_mfma_f32_32x32x16_bf16(b1,qr[d0],p1,0,0,0);}
}
typedef __attribute__((address_space(3))) const char* lds_cptr;
typedef short v4i16_t __attribute__((ext_vector_type(4)));
__device__ __forceinline__ void kload8(bf16x8*kf,lds_cptr kp){
  kf[0]=*(const __attribute__((address_space(3))) bf16x8*)(kp);      kf[1]=*(const __attribute__((address_space(3))) bf16x8*)(kp+512);
  kf[2]=*(const __attribute__((address_space(3))) bf16x8*)(kp+2048); kf[3]=*(const __attribute__((address_space(3))) bf16x8*)(kp+2560);
  kf[4]=*(const __attribute__((address_space(3))) bf16x8*)(kp+4096); kf[5]=*(const __attribute__((address_space(3))) bf16x8*)(kp+4608);
  kf[6]=*(const __attribute__((address_space(3))) bf16x8*)(kp+6144); kf[7]=*(const __attribute__((address_space(3))) bf16x8*)(kp+6656);
}
__device__ __forceinline__ void kload2(bf16x8*kf,lds_cptr kp,int j){ kf[2*j]=*(const __attribute__((address_space(3))) bf16x8*)(kp+j*2048); kf[2*j+1]=*(const __attribute__((address_space(3))) bf16x8*)(kp+j*2048+512); }
__device__ __forceinline__ s16x4 vtr(lds_cptr p){ return __builtin_bit_cast(s16x4,__builtin_amdgcn_ds_read_tr16_b64_v4i16((__attribute__((address_space(3))) v4i16_t*)p)); }
__device__ __forceinline__ float rowmax(const f32x16&p0,const f32x16&p1){
  float a=max3f(p0[0],p0[1],p1[0]),b=max3f(p0[2],p0[3],p1[1]);a=max3f(a,p1[2],p1[3]);
  #pragma unroll
  for(int r=4;r<16;r+=4){a=max3f(a,p0[r],p0[r+1]);b=max3f(b,p0[r+2],p0[r+3]);a=max3f(a,p1[r],p1[r+1]);b=max3f(b,p1[r+2],p1[r+3]);}
  const float m=max2f(a,b);
  auto rr=__builtin_amdgcn_permlane32_swap(__float_as_uint(m),__float_as_uint(m),false,false);
  return max2f(__uint_as_float(rr[0]),__uint_as_float(rr[1]));
}
__device__ __forceinline__ void pv(f32x16*o,int vb,bf16x8 pa0,bf16x8 pa1,bf16x8 pa2,bf16x8 pa3){
  #pragma unroll
  for(int d0=0;d0<2;++d0){s16x4 lo[4],hi[4];
    #pragma unroll
    for(int ks=0;ks<4;++ks){
      asm volatile("ds_read_b64_tr_b16 %0,%1 offset:%c2":"=&v"(lo[ks]):"v"(vb),"i"(d0*4096+ks*1024):"memory");
      asm volatile("ds_read_b64_tr_b16 %0,%1 offset:%c2":"=&v"(hi[ks]):"v"(vb),"i"(d0*4096+ks*1024+512):"memory");}
    asm volatile("s_waitcnt lgkmcnt(0)":::"memory");SBAR();
    #define PK(k) (bf16x8){lo[k][0],lo[k][1],lo[k][2],lo[k][3],hi[k][0],hi[k][1],hi[k][2],hi[k][3]}
    o[d0]=__builtin_amdgcn_mfma_f32_32x32x16_bf16(pa0,PK(0),o[d0],0,0,0);
    o[d0]=__builtin_amdgcn_mfma_f32_32x32x16_bf16(pa1,PK(1),o[d0],0,0,0);
    o[d0]=__builtin_amdgcn_mfma_f32_32x32x16_bf16(pa2,PK(2),o[d0],0,0,0);
    o[d0]=__builtin_amdgcn_mfma_f32_32x32x16_bf16(pa3,PK(3),o[d0],0,0,0);
    #undef PK
  }
}

#ifndef ATTN_STORE16
#define ATTN_STORE16(p,v) (*(u32x4*)(p)=(v))
#endif
template<int THRL> __device__ __forceinline__ void attn_unit(int tid,int b,int h,int qb,const bf16*Zb,const float*ksum,bf16*Yb,char*shm){
  const int lane=tid&63,r32=lane&31,hi=lane>>5; const int wid=__builtin_amdgcn_readfirstlane(tid>>6);
  const long rowbase=(long)b*SEQ; const int q0=qb*QB;
  const bf16*Qw=Zb+(rowbase+q0+wid*QBLK)*ZP+512+h*D;
  const bf16*Kh=Zb+rowbase*ZP+1024+h*D,*Vh=Zb+rowbase*ZP+1536+h*D;
  const unsigned lds0=(unsigned)(uintptr_t)shm;
  float*wsf=(float*)(shm+LDS_WS)+wid*64;
  const bf16*ksrc=Kh+(long)lane*ZP+wid*8;
  const bf16*vsrc=Vh+(long)(16*(wid&3)+(lane>>2))*ZP+(wid>>2)*32+(lane&3)*8;
  const unsigned kdst=lds0+LDS_K+wid*1024, vdst=lds0+LDS_V+wid*1024;
  #define DMA_K(t,slot) glds16(ksrc+(long)(t)*KVBLK*ZP,(unsigned)__builtin_amdgcn_readfirstlane(kdst+(slot)))
  #define DMA_V(t,slot) glds16(vsrc+(long)(t)*KVBLK*ZP,(unsigned)__builtin_amdgcn_readfirstlane(vdst+(slot)))
  const int vb0=(int)(lds0+LDS_V)+((lane>>4)&1)*32+(lane&3)*8+(4*hi+((lane&15)>>2))*64;
  const char*Kbase=shm+LDS_K; bf16x8 kf[8];
  const lds_cptr shm3=(lds_cptr)shm; const lds_cptr kp0=shm3+LDS_K+hi*1024+r32*16; const lds_cptr vp0=shm3+LDS_V+((lane>>4)&1)*32+(lane&3)*8+(4*hi+((lane&15)>>2))*64;
  const int NT=(q0+QB)/KVBLK;
  DMA_K(0,0);DMA_V(0,0);DMA_K(1,SLOTB);
  bf16x8 qr[4];
  #pragma unroll
  for(int d0=0;d0<4;++d0)qr[d0]=*reinterpret_cast<const bf16x8*>(&Qw[(long)r32*ZP+d0*16+hi*8]);
  const float slope2=__builtin_amdgcn_exp2f(-(float)(h+1))*1.4426950408889634f;
  unsigned selmask=(1u<<(qb+1))-1u;
  if(qb>3){ float g0=-INFINITY,g1=-INFINITY,g2=-INFINITY; int i0=0,i1=0,i2=0;
    float qf[32];
    #pragma unroll
    for(int d0=0;d0<4;++d0)
      #pragma unroll
      for(int j=0;j<8;++j)qf[d0*8+j]=__uint_as_float(((unsigned)(unsigned short)qr[d0][j])<<16);
    const float*ksb=ksum+((long)b*16)*512+h*D+hi*8;
    for(int j=0;j<qb;++j){ const float*kp=ksb+(long)j*512; float part=0.f;
      #pragma unroll
      for(int d0=0;d0<4;++d0){ const f32x4_t a0=*(const f32x4_t*)(kp+d0*16),a1=*(const f32x4_t*)(kp+d0*16+4),c0=*(const f32x4_t*)(kp+64*512+d0*16),c1=*(const f32x4_t*)(kp+64*512+d0*16+4);
        part+=qf[d0*8+0]*(a0[0]+c0[0])+qf[d0*8+1]*(a0[1]+c0[1])+qf[d0*8+2]*(a0[2]+c0[2])+qf[d0*8+3]*(a0[3]+c0[3])+qf[d0*8+4]*(a1[0]+c1[0])+qf[d0*8+5]*(a1[1]+c1[1])+qf[d0*8+6]*(a1[2]+c1[2])+qf[d0*8+7]*(a1[3]+c1[3]); }
      const float g=part+__shfl_xor(part,32);
      if(g>g0){g2=g1;i2=i1;g1=g0;i1=i0;g0=g;i0=j;} else if(g>g1){g2=g1;i2=i1;g1=g;i1=j;} else if(g>g2){g2=g;i2=j;} }
    selmask=(1u<<qb)|(1u<<i0)|(1u<<i1)|(1u<<i2); }
  float mhat=0.f,l_reg=0.f;f32x16 o[2];o[0]=f32x16{};o[1]=f32x16{};
  const float s1_=__uint_as_float(__builtin_amdgcn_readfirstlane(__float_as_uint(slope2))), s8_=8.f*s1_, s32_=32.f*s1_;
  const float hoff_=hi?4.f*s1_:0.f;
  #define CINIT(C0,C1,t) do{ const float lt0_=((selmask>>((t)>>2))&1u)?(s1_*(float)(64*(t)-q0)-mhat+hoff_):-1e30f; \
    C0[0]=lt0_; C0[4]=C0[0]+s8_; C0[8]=C0[4]+s8_; C0[12]=C0[8]+s8_; \
    _Pragma("unroll") for(int g_=0;g_<4;++g_){ C0[4*g_+1]=C0[4*g_]+s1_; C0[4*g_+2]=C0[4*g_+1]+s1_; C0[4*g_+3]=C0[4*g_+2]+s1_; } \
    _Pragma("unroll") for(int r=0;r<16;++r)C1[r]=C0[r]+s32_; }while(0)
  const int qrel=wid*QBLK+r32;
  #define CMASK(P0,P1,t) do{int jb_=(t)-(NT-4); if(jb_>=0)cmask(P0,P1,jb_,qrel,hi);}while(0)
  bool resc=false;
  #define START(P0,P1) do{ const float rm=rowmax(P0,P1); resc=false; \
    { const float dl=max2f(rm,0.f); mhat=fadd_s(mhat,dl); \
      _Pragma("unroll") for(int r=0;r<16;++r){P0[r]=fsub_s(P0[r],dl);P1[r]=fsub_s(P1[r],dl);} } \
    _Pragma("unroll") for(int r=0;r<16;++r)P0[r]=__builtin_amdgcn_exp2f(P0[r]); }while(0)
  #define RESC() do{ if(resc){ asm volatile("s_waitcnt lgkmcnt(0)":::"memory"); \
      _Pragma("unroll") for(int d_=0;d_<2;++d_) _Pragma("unroll") for(int r=0;r<16;++r)o[d_][r]*=wsf[crow(r,hi)]; } }while(0)
  f32x16 pA0,pA1,pB0,pB1;
  int sl_prev=0,sl_cur=0,sl_next=SLOTB;
  #define ROT() do{sl_prev=sl_cur;sl_cur=sl_next;sl_next=(sl_next==(NSLOT-1)*SLOTB)?0:sl_next+SLOTB;}while(0)
  DMA_K(2,2*SLOTB);
  WAIT_BAR(3);
  CINIT(pA0,pA1,0); qkt(pA0,pA1,Kbase,qr,r32,hi);asm volatile("s_nop 15\n\ts_nop 7":"+v"(pA0),"+v"(pA1));CMASK(pA0,pA1,0);
  START(pA0,pA1);
  _Pragma("unroll") for(int r=0;r<16;++r)pA1[r]=__builtin_amdgcn_exp2f(pA1[r]);
  WAIT_BAR(0);
  DMA_K(3,0);DMA_V(1,SLOTB);
  ROT();
  kload8(kf,kp0+sl_cur);
  WAIT_BAR(2);
  s16x4 vlo[8],vhi[8]; u32x4 pw0,pw1,pw2,pw3;
  #define PKW(P,B) cvtpk_s(P[B],P[B+1])
  #define PAF(k) __builtin_bit_cast(bf16x8,pw##k)
  #define VFR(i) (bf16x8){vlo[i][0],vlo[i][1],vlo[i][2],vlo[i][3],vhi[i][0],vhi[i][1],vhi[i][2],vhi[i][3]}
  #define PIN(x) asm volatile("":"+v"(x))
  #define MX3(a,b,c) __builtin_fmaxf(__builtin_fmaxf((a),(b)),(c))
  #define GAPA(MF,A0,A1,A2,A3,W0,W1,PW) do{ MF; sacc+=A0; sacc+=A1; sacc+=A2; sacc+=A3; PIN(sacc); W0; W1; PIN(PW); SBAR(); }while(0)
  #define EX(v) __builtin_amdgcn_exp2f(v)
  #define GAPB(MF,X,B) do{ MF; X[B]=EX(X[B]); X[B+1]=EX(X[B+1]); X[B+2]=EX(X[B+2]); X[B+3]=EX(X[B+3]); PIN(X); SBAR(); }while(0)
  #define VRD(i) do{ vlo[i]=vtr(vp_+(((i)>>2)*4096+((i)&3)*1024)); vhi[i]=vtr(vp_+(((i)>>2)*4096+((i)&3)*1024+512)); }while(0)
  #define KRD(G,j) do{ if(G){ kload2(kf,kp0+sl_next,j); SBAR(); } }while(0)
  #define STEP(C0,C1,P0,P1,t,GK,GV,GL) do{ SBAR(); \
    const lds_cptr vp_=vp0+sl_prev; \
    CINIT(C0,C1,t); PIN(C0); PIN(C1); SBAR(); \
    VRD(0); SBAR(); float sacc=(P0[0]+P0[1]); \
    GAPA(C0=__builtin_amdgcn_mfma_f32_32x32x16_bf16(kf[0],qr[0],C0,0,0,0), P0[2],P0[3],P0[4],P0[5],     pw0[0]=PKW(P0,0), pw0[1]=PKW(P0,2), pw0); \
    VRD(4); SBAR(); GAPA(C1=__builtin_amdgcn_mfma_f32_32x32x16_bf16(kf[1],qr[0],C1,0,0,0), P0[6],P0[7],P0[8],P0[9],     pw0[2]=PKW(P0,4), pw0[3]=PKW(P0,6), pw0); \
    VRD(1); SBAR(); GAPA(C0=__builtin_amdgcn_mfma_f32_32x32x16_bf16(kf[2],qr[1],C0,0,0,0),   P0[10],P0[11],P0[12],P0[13], pw1[0]=PKW(P0,8), pw1[1]=PKW(P0,10), pw1); \
    VRD(5); SBAR(); GAPA(C1=__builtin_amdgcn_mfma_f32_32x32x16_bf16(kf[3],qr[1],C1,0,0,0),   P0[14],P0[15],P1[0],P1[1],   pw1[2]=PKW(P0,12),pw1[3]=PKW(P0,14), pw1); \
    VRD(2); SBAR(); GAPA(C0=__builtin_amdgcn_mfma_f32_32x32x16_bf16(kf[4],qr[2],C0,0,0,0),   P1[2],P1[3],P1[4],P1[5],     pw2[0]=PKW(P1,0), pw2[1]=PKW(P1,2), pw2); \
    VRD(6); SBAR(); GAPA(C1=__builtin_amdgcn_mfma_f32_32x32x16_bf16(kf[5],qr[2],C1,0,0,0),   P1[6],P1[7],P1[8],P1[9],     pw2[2]=PKW(P1,4), pw2[3]=PKW(P1,6), pw2); \
    VRD(3); SBAR(); GAPA(C0=__builtin_amdgcn_mfma_f32_32x32x16_bf16(kf[6],qr[3],C0,0,0,0),   P1[10],P1[11],P1[12],P1[13], pw3[0]=PKW(P1,8), pw3[1]=PKW(P1,10), pw3); \
    VRD(7); SBAR(); GAPA(C1=__builtin_amdgcn_mfma_f32_32x32x16_bf16(kf[7],qr[3],C1,0,0,0),   P1[14],P1[15],0.f,0.f,       pw3[2]=PKW(P1,12),pw3[3]=PKW(P1,14), pw3); \
    l_reg+=sacc; \
    if(GK){DMA_K((t)+3,sl_cur);} if(GV){DMA_V((t)+1,sl_next);} \
    CMASK(C0,C1,t); \
    { float a=MX3(C0[0],C0[1],C1[0]),b=MX3(C0[2],C0[3],C1[1]); a=MX3(a,C1[2],C1[3]); \
      _Pragma("unroll") for(int r=4;r<16;r+=4){a=MX3(a,C0[r],C0[r+1]);b=MX3(b,C0[r+2],C0[r+3]);a=MX3(a,C1[r],C1[r+1]);b=MX3(b,C1[r+2],C1[r+3]);} \
      float rm=__builtin_fmaxf(a,b); { auto rr=__builtin_amdgcn_permlane32_swap(__float_as_uint(rm),__float_as_uint(rm),false,false); rm=__builtin_fmaxf(__uint_as_float(rr[0]),__uint_as_float(rr[1])); } \
      resc=false; \
      if(__builtin_expect(__any(rm>(float)THRL),0)){ const float dl=__builtin_fmaxf(rm,0.f); mhat+=dl; \
        _Pragma("unroll") for(int r=0;r<16;++r){C0[r]-=dl;C1[r]-=dl;} \
        const float f=__builtin_amdgcn_exp2f(-dl); l_reg*=f; if(hi==0)wsf[r32]=f; resc=true; } } \
    SBAR(); \
    GAPB(o[0]=__builtin_amdgcn_mfma_f32_32x32x16_bf16(PAF(0),VFR(0),o[0],0,0,0), C0,0); \
    GAPB(o[1]=__builtin_amdgcn_mfma_f32_32x32x16_bf16(PAF(0),VFR(4),o[1],0,0,0), C0,4); \
    KRD(GL,0); GAPB(o[0]=__builtin_amdgcn_mfma_f32_32x32x16_bf16(PAF(1),VFR(1),o[0],0,0,0), C0,8); \
    KRD(GL,1); GAPB(o[1]=__builtin_amdgcn_mfma_f32_32x32x16_bf16(PAF(1),VFR(5),o[1],0,0,0), C0,12); \
    KRD(GL,2); GAPB(o[0]=__builtin_amdgcn_mfma_f32_32x32x16_bf16(PAF(2),VFR(2),o[0],0,0,0), C1,0); \
    KRD(GL,3); GAPB(o[1]=__builtin_amdgcn_mfma_f32_32x32x16_bf16(PAF(2),VFR(6),o[1],0,0,0), C1,4); \
    GAPB(o[0]=__builtin_amdgcn_mfma_f32_32x32x16_bf16(PAF(3),VFR(3),o[0],0,0,0), C1,8); \
    GAPB(o[1]=__builtin_amdgcn_mfma_f32_32x32x16_bf16(PAF(3),VFR(7),o[1],0,0,0), C1,12); \
    }while(0)
  int t=1;
  #undef CMASK
  #define CMASK(P0,P1,t) do{}while(0)
  for(;t+5<NT;t+=2){
    STEP(pB0,pB1,pA0,pA1,t,true,true,true);     WAIT_BAR(2); RESC(); ROT();
    STEP(pA0,pA1,pB0,pB1,t+1,true,true,true);   WAIT_BAR(2); RESC(); ROT();
  }
  #undef CMASK
  #define CMASK(P0,P1,t) do{int jb_=(t)-(NT-4); if(jb_>=0)cmask(P0,P1,jb_,qrel,hi);}while(0)
  #define ENDW(tt) do{ if((tt)+3<NT){WAIT_BAR(2);} else if((tt)+2<NT){WAIT_BAR(1);} else {WAIT_BAR(0);} }while(0)
  for(;t+1<NT;t+=2){
    STEP(pB0,pB1,pA0,pA1,t,(t+3<NT),(t+1<NT),(t+1<NT));       ENDW(t);   RESC(); ROT();
    STEP(pA0,pA1,pB0,pB1,t+1,(t+4<NT),(t+2<NT),(t+2<NT));     ENDW(t+1); RESC(); ROT();
  }
  STEP(pB0,pB1,pA0,pA1,NT-1,false,false,false); RESC();
  { float sacc=pB0[0]+pB0[1]; _Pragma("unroll") for(int r=2;r<16;++r)sacc+=pB0[r]; _Pragma("unroll") for(int r=0;r<16;++r)sacc+=pB1[r]; l_reg+=sacc;
    pw0=(u32x4){PKW(pB0,0),PKW(pB0,2),PKW(pB0,4),PKW(pB0,6)};pw1=(u32x4){PKW(pB0,8),PKW(pB0,10),PKW(pB0,12),PKW(pB0,14)};pw2=(u32x4){PKW(pB1,0),PKW(pB1,2),PKW(pB1,4),PKW(pB1,6)};pw3=(u32x4){PKW(pB1,8),PKW(pB1,10),PKW(pB1,12),PKW(pB1,14)};
    SBAR(); pv(o,vb0+sl_cur,PAF(0),PAF(1),PAF(2),PAF(3)); }
  #undef PKW
  #undef PAF
  #undef VFR
  #undef PIN
  #undef MX3
  #undef GAPA
  #undef GAPB
  #undef EX
  #undef VRD
  #undef KRD
  #undef STEP
  #undef ENDW
  {auto rr=__builtin_amdgcn_permlane32_swap(__float_as_uint(l_reg),__float_as_uint(l_reg),false,false);l_reg=__uint_as_float(rr[0])+__uint_as_float(rr[1]);}
  if(hi==0)wsf[32+r32]=l_reg;asm volatile("s_waitcnt lgkmcnt(0)":::"memory");
  float rli[16];
  #pragma unroll
  for(int r=0;r<16;++r)rli[r]=__builtin_amdgcn_rcpf(wsf[32+crow(r,hi)]);
  bf16*Ow=Yb+(rowbase+q0+wid*QBLK)*YP+256+h*D;
  { bf16*stg=(bf16*)(shm+LDS_OST)+wid*2048;
    #pragma unroll
    for(int r=0;r<16;++r){const int orow=crow(r,hi);
      #pragma unroll
      for(int d0=0;d0<2;++d0)stg[orow*64+d0*32+r32]=__float2bfloat16(o[d0][r]*rli[r]);}
    asm volatile("s_waitcnt lgkmcnt(0)":::"memory");
    #pragma unroll
    for(int i=0;i<4;++i){const int row=i*8+(lane>>3),ch=lane&7; const u32x4 v=*(const u32x4*)(stg+row*64+ch*8); ATTN_STORE16(Ow+(long)row*YP+ch*8,v);} }
  asm volatile("s_waitcnt lgkmcnt(0)\n\ts_barrier":::"memory");
  #undef CINIT
  #undef DMA_K
  #undef DMA_V
  #undef CMASK
  #undef START
  #undef RESC
  #undef ROT
}
constexpr int ATTN_LDS_BYTES=LDS_BYTES;
#undef SBAR
#undef WAIT_BAR
}

#define XB_TMO      128
#define XB_XCNT(j)  (256  + 64 * (j))
#define XB_XSUB(j)  (1280 + 64 * (j))
#define XB_XGEN(j)  (2304 + 64 * (j))
#define XB_TOP      3328
#define XB_TOPGEN   3392
#define XCD_BAR_WORDS 3456
#define XB_SPIN_CAP (1u << 20)
constexpr int CW_BAR = 4096;
constexpr int MISC_OFF = 131072 + 320;
__device__ __forceinline__ unsigned xb_ld(unsigned* p)              { return __hip_atomic_load(p, __ATOMIC_RELAXED, __HIP_MEMORY_SCOPE_AGENT); }
__device__ __forceinline__ unsigned xb_add(unsigned* p, unsigned v) { return __hip_atomic_fetch_add(p, v, __ATOMIC_RELAXED, __HIP_MEMORY_SCOPE_AGENT); }
__device__ __forceinline__ unsigned xb_xcc_id() { return (unsigned)__builtin_amdgcn_s_getreg((3 << 11) | 20) & 0xFu; }
#define XB_SPIN(cond, bar) do { unsigned _sp = 0; while (cond) { __builtin_amdgcn_s_sleep(1); \
    if ((++_sp & 255u) == 0u) { if (xb_ld(&(bar)[XB_TMO])) break; if (_sp > XB_SPIN_CAP) { atomicAdd(&(bar)[XB_TMO], 1u); break; } } } } while (0)
struct XcdBarrier { unsigned* bar; unsigned x; volatile LAS unsigned* st; };
__device__ __forceinline__ XcdBarrier xcd_barrier_post(unsigned* bar, volatile LAS unsigned* st, int tid) {
    XcdBarrier b; b.bar = bar; b.x = xb_xcc_id(); b.st = st;
    if (tid == 0) (void)xb_add(&bar[XB_XCNT(b.x)], 1u);
    return b;
}
__device__ __forceinline__ void xcd_barrier_complete(unsigned* bar, unsigned x, unsigned G, unsigned& nloc, unsigned& nx) {
    unsigned sum, cnt, mine, sp = 0u;
    for (;;) {
        sum = 0u; cnt = 0u; mine = 0u;
#pragma unroll
        for (unsigned j = 0; j < 16; ++j) { const unsigned c = xb_ld(&bar[XB_XCNT(j)]); sum += c; cnt += (c > 0u) ? 1u : 0u; mine = (j == x) ? c : mine; }
        if (sum == G) break;
        __builtin_amdgcn_s_sleep(1);
        if ((++sp & 255u) == 0u) { if (xb_ld(&bar[XB_TMO])) break; if (sp > XB_SPIN_CAP) { atomicAdd(&bar[XB_TMO], 1u); break; } }
    }
    nloc = mine > 0u ? mine : 1u; nx = cnt > 0u ? cnt : 1u;
}
__device__ __forceinline__ void xcd_barrier(const XcdBarrier& b, int tid, unsigned G) {
    asm volatile("s_waitcnt vmcnt(0)" ::: "memory");
    __syncthreads();
    if (tid == 0) {
        unsigned* bar = b.bar;
        __builtin_amdgcn_s_waitcnt(0);
        unsigned nloc = b.st[0], nx = b.st[1];
        if (nloc == 0u) { xcd_barrier_complete(bar, b.x, G, nloc, nx); b.st[0] = nloc; b.st[1] = nx; }
        const unsigned old = xb_add(&bar[XB_XSUB(b.x)], 1u);
        const unsigned gen = old / nloc;
        if (old + 1u == (gen + 1u) * nloc) {
            __builtin_amdgcn_fence(__ATOMIC_RELEASE, "agent");
            asm volatile("s_waitcnt vmcnt(0)" ::: "memory");
            const unsigned og = xb_add(&bar[XB_TOP], 1u);
            const unsigned tg = og / nx;
            if (og + 1u == (tg + 1u) * nx) xb_add(&bar[XB_TOPGEN], 1u);
            else XB_SPIN(xb_ld(&bar[XB_TOPGEN]) == tg, bar);
            __builtin_amdgcn_fence(__ATOMIC_ACQUIRE, "agent");
            xb_add(&bar[XB_XGEN(b.x)], 1u);
            asm volatile("s_waitcnt vmcnt(0)" ::: "memory");
        } else {
            XB_SPIN(xb_ld(&bar[XB_XGEN(b.x)]) == gen, bar);
            __builtin_amdgcn_fence(__ATOMIC_ACQUIRE, "agent");
            asm volatile("s_waitcnt vmcnt(0)" ::: "memory");
        }
    }
    __syncthreads();
}

constexpr int NWAVES = 8;
constexpr int LDS_BYTES = 147456;
__global__ void __launch_bounds__(NWAVES * 64, 2) mk_fwd(Args args) {
    extern __shared__ __attribute__((aligned(16))) unsigned char lds_raw[];
    LAS unsigned char* lds = (LAS unsigned char*)lds_raw;
    const int wave0 = __builtin_amdgcn_readfirstlane(threadIdx.x >> 6);
    const int G0 = gridDim.x, bx0 = blockIdx.x;
    { int t0; asm volatile("v_mbcnt_lo_u32_b32 %0, -1, 0\n\tv_mbcnt_hi_u32_b32 %0, -1, %0" : "=v"(t0)); t0 += wave0 * 64;
      for (int u = t0; u < 256; u += NWAVES * 64) ((LAS unsigned*)(lds + 131072))[u] = 0u; }
    __syncthreads();
    KArgs ap0 = (KArgs)__builtin_amdgcn_kernarg_segment_ptr();
    XcdBarrier gbar; { int t0; asm volatile("v_mbcnt_lo_u32_b32 %0, -1, 0\n\tv_mbcnt_hi_u32_b32 %0, -1, %0" : "=v"(t0)); t0 += wave0 * 64;
      gbar = xcd_barrier_post((unsigned*)as_global(ap0->ws) + CW_BAR, (volatile LAS unsigned*)(lds + MISC_OFF) + 8, t0); }
    const int ph_lo = ap0->ph_lo, ph_hi = ap0->ph_hi;
    for (int p = ph_lo; p < ph_hi; ++p) {
        const int l = p / PH_PER_LAYER, type = p % PH_PER_LAYER;
        KArgs ap = ap0; asm volatile("" : "+s"(ap));
        int G = G0, bx = bx0; asm volatile("" : "+s"(G), "+s"(bx));
        const int vcu = (G % 8 == 0) ? (bx % 8) * (G / 8) + bx / 8 : bx, NGW = G * NWAVES;
        int tid; asm volatile("v_mbcnt_lo_u32_b32 %0, -1, 0\n\tv_mbcnt_hi_u32_b32 %0, -1, %0" : "=v"(tid)); tid += wave0 * 64;
        const int lane = tid & 63, wave = __builtin_amdgcn_readfirstlane(tid >> 6);
        const int gw = vcu * NWAVES + wave;
        unsigned char* ws = as_global(ap->ws);
        switch (type) {
        case PH_PRO: phase_pro(ap, l, lds, gw, NGW, wave, lane); break;
        case PH_NORM1: phase_norm(ap, as_global(ap->in[13]) + (size_t)l * DM, as_global(ap->in[14]) + (size_t)l * DM, gw, NGW, lane); break;
        case PH_NORM2: phase_norm(ap, as_global(ap->in[19]) + (size_t)l * DM, as_global(ap->in[20]) + (size_t)l * DM, gw, NGW, lane); break;
        case PH_NORM3: phase_norm(ap, as_global(ap->in[23]) + (size_t)l * DM, (l + 1 < DEPTH) ? as_global(ap->in[2]) + (size_t)(l + 1) * DM : nullptr, gw, NGW, lane); break;
        case PH_KV: { pg8::GemmP g{}; g.A = (const bf16*)(ws + WS_MN); g.Bt = (const bf16*)(ws + WS_WT_XKV); g.lda = DM; g.ldb = DM; g.K = DM; g.nM = BATCH * MEML / 256; g.nN = 2 * DM / 256; g.nZ = 1; g.zdiv = 1; g.b_pm_div = 1 << 30;
            pg8::Sched S; S.init(g, G, bx); pg8::Epi<pg8::EM_BF16> E{ws + WS_KV, 2 * DM, 1.f, 1, 0, 0, nullptr}; pg8::gemm_phase(tid, lds, g, S, E); } break;
        case PH_FOLD: {
            { pg8::GemmP g{}; g.A = (const bf16*)(ws + WS_KV); g.lda = 2 * DM; g.a_s1 = (size_t)MEML * 2 * DM; g.a_s2 = XHD; g.Bt = (const bf16*)(ws + WS_WN_XQ); g.ldb = DM; g.b_s1 = 0; g.b_s2 = XHD; g.K = XHD; g.nM = 1; g.nN = DM / 256; g.nZ = BATCH * XH; g.zdiv = XH; g.b_pm_div = 1 << 30;
              pg8::Sched S; S.init(g, G, bx); pg8::Epi<pg8::EM_BF16> E{ws + WS_WQK, DM, XSC, XH, (size_t)DM * DM, (size_t)MEML * DM, nullptr}; pg8::gemm_phase(tid, lds, g, S, E); }
            { pg8::GemmP g{}; g.A = (const bf16*)(ws + WS_WT_XO); g.lda = DM; g.a_s1 = 0; g.a_s2 = XHD; g.Bt = (const bf16*)(ws + WS_KV) + DM; g.ldb = 2 * DM; g.b_s1 = (size_t)MEML * 2 * DM; g.b_s2 = XHD; g.K = XHD; g.nM = DM / 256; g.nN = 1; g.nZ = BATCH * XH; g.zdiv = XH; g.b_pm_div = 1 << 30;
              pg8::Sched S; S.init(g, G, bx); pg8::Epi<pg8::EM_BF16> E{ws + WS_WVO, DM, 1.f, XH, (size_t)DM * DM, (size_t)MEML, nullptr}; pg8::gemm_phase(tid, lds, g, S, E); }
            } break;
        case PH_INPROJ: { pg8::GemmP g{}; g.A = (const bf16*)(ws + WS_XN); g.Bt = (const bf16*)(ws + WS_WT_IN); g.lda = DM; g.ldb = DM; g.K = DM; g.nM = M / 256; g.nN = INC / 256; g.nZ = 1; g.zdiv = 1; g.b_pm_div = 1 << 30;
            pg8::Sched S; S.init(g, G, bx); pg8::Epi<pg8::EM_INPROJ> E{ws + WS_Z, INC, 1.f, 1, 0, 0, (float*)(ws + WS_KSUM)}; pg8::gemm_phase(tid, lds, g, S, E); } break;
        case PH_OUTPROJ: { pg8::GemmP g{}; g.A = (const bf16*)(ws + WS_Y); g.Bt = (const bf16*)(ws + WS_WT_OUT); g.lda = DM; g.ldb = DM; g.K = DM; g.nM = M / 256; g.nN = DM / 256; g.nZ = 1; g.zdiv = 1; g.b_pm_div = 1 << 30;
            pg8::Sched S; S.init(g, G, bx); pg8::Epi<pg8::EM_F32> E{ws + WS_T, DM, 1.f, 1, 0, 0, nullptr}; pg8::gemm_phase(tid, lds, g, S, E); } break;
        case PH_SGEMM: { pg8::GemmP g{}; g.A = (const bf16*)(ws + WS_XN); g.Bt = (const bf16*)(ws + WS_WQK); g.lda = DM; g.ldb = DM; g.K = DM; g.nM = M / 256; g.nN = DM / 256; g.nZ = 1; g.zdiv = 1; g.b_pm_div = SEQ / 256; g.b_pm_stride = (size_t)DM * DM;
            pg8::Sched S; S.init(g, G, bx); pg8::Epi<pg8::EM_SOFTMAX> E{ws + WS_P, DM, 1.f, 1, 0, 0, nullptr}; pg8::gemm_phase(tid, lds, g, S, E); } break;
        case PH_PVOUT: { pg8::GemmP g{}; g.A = (const bf16*)(ws + WS_P); g.Bt = (const bf16*)(ws + WS_WVO); g.lda = DM; g.ldb = DM; g.K = DM; g.nM = M / 256; g.nN = DM / 256; g.nZ = 1; g.zdiv = 1; g.b_pm_div = SEQ / 256; g.b_pm_stride = (size_t)DM * DM;
            pg8::Sched S; S.init(g, G, bx); pg8::Epi<pg8::EM_F32> E{ws + WS_T, DM, 1.f, 1, 0, 0, nullptr}; pg8::gemm_phase(tid, lds, g, S, E); } break;
        case PH_FF1: { pg8::GemmP g{}; g.A = (const bf16*)(ws + WS_XN); g.Bt = (const bf16*)(ws + WS_WT_FF1); g.lda = DM; g.ldb = DM; g.K = DM; g.nM = M / 256; g.nN = DFF / 256; g.nZ = 1; g.zdiv = 1; g.b_pm_div = 1 << 30;
            pg8::Sched S; S.init(g, G, bx); pg8::Epi<pg8::EM_RELU2> E{ws + WS_H, DFF, 1.f, 1, 0, 0, nullptr}; pg8::gemm_phase(tid, lds, g, S, E); } break;
        case PH_FF2: { pg8::GemmP g{}; g.A = (const bf16*)(ws + WS_H); g.Bt = (const bf16*)(ws + WS_WT_FF2); g.lda = DFF; g.ldb = DFF; g.K = DFF; g.nM = M / 256; g.nN = DM / 256; g.nZ = 1; g.zdiv = 1; g.b_pm_div = 1 << 30;
            pg8::Sched S; S.init(g, G, bx); pg8::Epi<pg8::EM_F32> E{ws + WS_T, DM, 1.f, 1, 0, 0, nullptr}; pg8::gemm_phase(tid, lds, g, S, E); } break;
        case PH_MIXER: {
            const bf16* Z = (const bf16*)(ws + WS_Z); bf16* Y = (bf16*)(ws + WS_Y);
            for (int u = vcu; u < M / CHUNK; u += G) mix::gmlp_unit(tid, u, Z, as_global(ap->in[4]) + (size_t)l * AW, as_global(ap->in[5]) + (size_t)l * AW, as_global(ap->in[6]) + (size_t)l * AH * CHUNK * CHUNK, as_global(ap->in[7]) + (size_t)l * AH * CHUNK, Y, lds);
            for (int u = vcu; u < M / 64; u += G) mix::conv_unit(tid, u, Z, as_global(ap->in[8]) + (size_t)l * CONVW * CW, as_global(ap->in[9]) + (size_t)l * CW, as_global(ap->in[10]) + (size_t)l * CW, as_global(ap->in[11]) + (size_t)l * CW, Y, lds);
            for (int vv = vcu; vv < 256; vv += G)
                for (int i = 0; i < 2; ++i) { const int bh = vv >> 3, sq = vv & 7; int tid2 = tid; asm volatile("" : "+v"(tid2));
                    moba::attn_unit<8>(tid2, bh / BH, bh % BH, i ? 15 - sq : sq, (const moba::bf16*)Z, (const float*)(ws + WS_KSUM), (moba::bf16*)Y, (char*)lds_raw); }
            } break;
        default: break;
        }
        if (p + 1 < ph_hi) xcd_barrier(gbar, tid, (unsigned)G);
    }
}

enum NaiveMode { NM_F32 = 0, NM_BF16, NM_INPROJ, NM_RELU2 };
struct NaiveGemm { const bf16* A; int lda; const bf16* Bt; int ldb; size_t b_batch_stride; int rows_per_batch; int Mr, N, K; int mode; void* C; int ldc; float scale; };
__global__ void __launch_bounds__(256) naive_gemm(NaiveGemm g) {
    __shared__ __attribute__((aligned(16))) float As[32][68], Bs[32][68];
    const int tx = threadIdx.x & 15, ty = threadIdx.x >> 4; const int row0 = blockIdx.y * 64, col0 = blockIdx.x * 64;
    const bf16* Bt = g.Bt + (size_t)(row0 / g.rows_per_batch) * g.b_batch_stride;
    float acc[4][4] = {};
    for (int k0 = 0; k0 < g.K; k0 += 32) {
        for (int i = threadIdx.x; i < 64 * 32; i += 256) { const int r = i >> 5, c = i & 31; As[c][r] = bf2f(g.A[(size_t)(row0 + r) * g.lda + k0 + c]); Bs[c][r] = bf2f(Bt[(size_t)(col0 + r) * g.ldb + k0 + c]); }
        __syncthreads();
#pragma unroll 8
        for (int k = 0; k < 32; ++k) { float av[4], bv[4];
            { const f32x4 a4 = *(const f32x4*)&As[k][ty * 4], b4 = *(const f32x4*)&Bs[k][tx * 4]; av[0] = a4.x; av[1] = a4.y; av[2] = a4.z; av[3] = a4.w; bv[0] = b4.x; bv[1] = b4.y; bv[2] = b4.z; bv[3] = b4.w; }
#pragma unroll
            for (int i = 0; i < 4; ++i)
#pragma unroll
                for (int j = 0; j < 4; ++j) acc[i][j] += av[i] * bv[j]; }
        __syncthreads();
    }
    for (int i = 0; i < 4; ++i) for (int j = 0; j < 4; ++j) {
        const int r = row0 + ty * 4 + i, c = col0 + tx * 4 + j; float v = acc[i][j] * g.scale;
        if (g.mode == NM_F32) ((float*)g.C)[(size_t)r * g.ldc + c] = v;
        else { if (g.mode == NM_INPROJ) { if (c < 2 * AW) v = 0.5f * v * (1.0f + erff(v * 0.70710678118654752f)); else if (c < ZK) v *= C2; }
               else if (g.mode == NM_RELU2) { v = v > 0.f ? v * v : 0.f; }
               ((bf16*)g.C)[(size_t)r * g.ldc + c] = (bf16)f2bf(v); }
    }
}
__global__ void naive_ksum(const bf16* Z, float* ksum) {
    const int i = blockIdx.x * blockDim.x + threadIdx.x; if (i >= 64 * 512) return; const int blk = i / 512, c = i % 512; float s = 0.f;
    for (int r = 0; r < MBLK; ++r) s += bf2f(Z[(size_t)(blk * MBLK + r) * INC + ZK + c]);
    ksum[i] = s; ksum[64 * 512 + i] = 0.f;
}
__global__ void __launch_bounds__(64) naive_moba(const bf16* Z, const float* ksum, bf16* Y) {
    __shared__ float ps[4 * MBLK]; __shared__ float qs[HD];
    const int lane = threadIdx.x; const int id = blockIdx.x; const int t = id % SEQ, h = (id / SEQ) % BH, b = id / (SEQ * BH);
    const size_t row = (size_t)b * SEQ + t; const int own = t / MBLK;
    const float qd = bf2f(Z[row * INC + ZQ + h * HD + lane]); qs[lane] = qd; __syncthreads();
    int sel[4]; int nsel = 0; float best[3] = {-INFINITY, -INFINITY, -INFINITY}; int bidx[3] = {-1, -1, -1};
    for (int j = 0; j < own; ++j) { const float* ks = ksum + (size_t)(b * 16 + j) * 512 + h * HD; const float g = wave_sum(qd * (ks[lane] + ks[64 * 512 + lane]));
        if (g > best[0]) { best[2] = best[1]; bidx[2] = bidx[1]; best[1] = best[0]; bidx[1] = bidx[0]; best[0] = g; bidx[0] = j; }
        else if (g > best[1]) { best[2] = best[1]; bidx[2] = bidx[1]; best[1] = g; bidx[1] = j; }
        else if (g > best[2]) { best[2] = g; bidx[2] = j; } }
    for (int i = 0; i < 3; ++i) if (bidx[i] >= 0) sel[nsel++] = bidx[i];
    sel[nsel++] = own;
    const float slope2 = exp2f(-(float)(h + 1)) * LOG2E;
    float mx = -INFINITY;
    for (int s = 0; s < nsel; ++s) for (int kk = lane; kk < MBLK; kk += 64) { const int kpos = sel[s] * MBLK + kk; float sc = -INFINITY;
        if (kpos <= t) { const bf16* kr = Z + ((size_t)b * SEQ + kpos) * INC + ZK + h * HD; float d = 0.f; for (int e = 0; e < HD; ++e) d += qs[e] * bf2f(kr[e]); sc = d - slope2 * (float)(t - kpos); }
        ps[s * MBLK + kk] = sc; mx = fmaxf(mx, sc); }
    mx = wave_max(mx); float sum = 0.f;
    for (int s = 0; s < nsel; ++s) for (int kk = lane; kk < MBLK; kk += 64) { const float p = exp2f(ps[s * MBLK + kk] - mx); ps[s * MBLK + kk] = p; sum += p; }
    sum = wave_sum(sum); __syncthreads();
    float o = 0.f;
    for (int s = 0; s < nsel; ++s) for (int kk = 0; kk < MBLK; ++kk) { const int kpos = sel[s] * MBLK + kk; if (kpos > t) break; o += ps[s * MBLK + kk] * bf2f(Z[((size_t)b * SEQ + kpos) * INC + ZV + h * HD + lane]); }
    Y[row * DM + AW + h * HD + lane] = (bf16)f2bf(o / sum);
}
__global__ void __launch_bounds__(64) naive_gmlp_ln(const bf16* Z, const float* g, const float* bta, float* vn) {
    const int row = blockIdx.x, lane = threadIdx.x; float v[4]; float s = 0.f;
    for (int j = 0; j < 4; ++j) { v[j] = bf2f(Z[(size_t)row * INC + AW + lane + 64 * j]); s += v[j]; }
    const float mu = wave_sum(s) * (1.f / AW); float q = 0.f; for (int j = 0; j < 4; ++j) { v[j] -= mu; q += v[j] * v[j]; }
    const float rstd = 1.0f / sqrtf(wave_sum(q) * (1.f / AW) + EPS);
    for (int j = 0; j < 4; ++j) { const int c = lane + 64 * j; vn[(size_t)row * AW + c] = v[j] * rstd * g[c] + bta[c]; }
}
__global__ void __launch_bounds__(256) naive_gmlp_gate(const bf16* Z, const float* vn, const float* w_s, const float* b_s, bf16* Y) {
    const int row = blockIdx.x, c = threadIdx.x, h = c / HD; const int tt = row % CHUNK; const int row0 = row - tt;
    float acc = b_s[h * CHUNK + tt]; const float* w = w_s + ((size_t)h * CHUNK + tt) * CHUNK;
    for (int ss = 0; ss <= tt; ++ss) acc += w[ss] * vn[(size_t)(row0 + ss) * AW + c];
    Y[(size_t)row * DM + c] = (bf16)f2bf(bf2f(Z[(size_t)row * INC + c]) * acc);
}
__global__ void __launch_bounds__(64) naive_conv(const bf16* Z, const float* w_dw, const float* b_dw, const float* gg, const float* gb, bf16* Y) {
    const int row = blockIdx.x / CG, grp = blockIdx.x % CG, lane = threadIdx.x, c = grp * HD + lane; const int t = row % SEQ;
    float acc = b_dw[c];
    for (int w = 0; w < CONVW; ++w) { const int tt = t - (CONVW - 1) + w; if (tt < 0) continue; const size_t r2 = (size_t)(row - t + tt);
        const float av = bf2f(Z[r2 * INC + ZC + c]), gv = bf2f(Z[r2 * INC + ZC + CW + c]); acc += w_dw[w * CW + c] * (av / (1.0f + expf(-gv))); }
    const float mu = wave_sum(acc) * (1.f / HD); const float d = acc - mu; const float rstd = 1.0f / sqrtf(wave_sum(d * d) * (1.f / HD) + EPS);
    const float y = d * rstd * gg[c] + gb[c];
    Y[(size_t)row * DM + AW + BW + c] = (bf16)f2bf(y / (1.0f + expf(-y)));
}
__global__ void __launch_bounds__(64) naive_softmax(const float* T, bf16* P) {
    const int row = blockIdx.x / XH, h = blockIdx.x % XH, lane = threadIdx.x; float v[4]; float mx = -INFINITY;
    for (int j = 0; j < 4; ++j) { v[j] = T[(size_t)row * DM + h * MEML + lane + 64 * j]; mx = fmaxf(mx, v[j]); }
    mx = wave_max(mx); float s = 0.f; for (int j = 0; j < 4; ++j) { v[j] = exp2f(v[j] - mx); s += v[j]; }
    s = wave_sum(s); for (int j = 0; j < 4; ++j) P[(size_t)row * DM + h * MEML + lane + 64 * j] = (bf16)f2bf(v[j] / s);
}

static void launch_naive_gemm(hipStream_t st, const bf16* A, int lda, const bf16* Bt, int ldb, size_t bstride, int rpb, int Mr, int N, int K, int mode, void* C, int ldc, float scale) {
    NaiveGemm g{A, lda, Bt, ldb, bstride, rpb, Mr, N, K, mode, C, ldc, scale};
    hipLaunchKernelGGL(naive_gemm, dim3(N / 64, Mr / 64), dim3(256), 0, st, g);
}

#ifndef ONE_LAUNCH
#define ONE_LAUNCH 1
#endif
#ifndef IMPL_MASK
#define IMPL_MASK 0xDBEu
#endif
extern "C" void kernel_launch(void* const* d_in, const int* in_sizes, int n_in, void* d_out, int out_size, void* d_ws, size_t ws_size, hipStream_t stream) {
    static int grid = 0;
    if (grid == 0) {
        if (n_in != 24 || in_sizes[0] != M * DM || out_size != M * DM || ws_size < WS_END) { fprintf(stderr, "kernel_launch: unexpected shapes (n_in %d in0 %d out %d ws %zu)\n", n_in, n_in > 0 ? in_sizes[0] : -1, out_size, ws_size); grid = -1; return; }
        int dev = 0, cus = 0, per_cu = 0;
        if (hipGetDevice(&dev) != hipSuccess || hipDeviceGetAttribute(&cus, hipDeviceAttributeMultiprocessorCount, dev) != hipSuccess) { grid = -1; return; }
        if (hipFuncSetAttribute((const void*)mk_fwd, hipFuncAttributeMaxDynamicSharedMemorySize, LDS_BYTES) != hipSuccess) { fprintf(stderr, "kernel_launch: hipFuncSetAttribute failed\n"); grid = -1; return; }
        if (hipOccupancyMaxActiveBlocksPerMultiprocessor(&per_cu, (const void*)mk_fwd, NWAVES * 64, LDS_BYTES) != hipSuccess || per_cu < 1) { fprintf(stderr, "kernel_launch: occupancy query says %d\n", per_cu); per_cu = 1; }
        (void)hipGetLastError();
        grid = cus;
    }
    if (grid < 0) return;
    Args a{};
    for (int i = 0; i < 24; ++i) a.in[i] = (GAS const float*)d_in[i];
    a.out = (GAS float*)d_out; a.ws = (GAS unsigned char*)d_ws;
    unsigned char* ws = (unsigned char*)d_ws;
    const unsigned always_mk = (1u << PH_PRO) | (1u << PH_NORM1) | (1u << PH_NORM2) | (1u << PH_NORM3);
    const unsigned mk_mask = always_mk | (IMPL_MASK);
    bf16* XN = (bf16*)(ws + WS_XN); bf16* Z = (bf16*)(ws + WS_Z); bf16* Y = (bf16*)(ws + WS_Y); bf16* P = (bf16*)(ws + WS_P); bf16* H = (bf16*)(ws + WS_H);
    float* T = (float*)(ws + WS_T); float* KS = (float*)(ws + WS_KSUM); bf16* KV = (bf16*)(ws + WS_KV); bf16* WQK = (bf16*)(ws + WS_WQK); bf16* WVO = (bf16*)(ws + WS_WVO);
    if (hipMemsetAsync(ws + WS_CTL, 0, CTL_ZERO_BYTES, stream) != hipSuccess) { fprintf(stderr, "kernel_launch: memset failed\n"); return; }
    if (ONE_LAUNCH) { a.ph_lo = 0; a.ph_hi = NPH; hipLaunchKernelGGL(mk_fwd, dim3(grid), dim3(NWAVES * 64), LDS_BYTES, stream, a); return; }
    for (int p = 0; p < NPH; ++p) {
        const int l = p / PH_PER_LAYER, type = p % PH_PER_LAYER;
        if (mk_mask & (1u << type)) { a.ph_lo = p; a.ph_hi = p + 1; hipLaunchKernelGGL(mk_fwd, dim3(grid), dim3(NWAVES * 64), LDS_BYTES, stream, a); continue; }
        switch (type) {
        case PH_KV: launch_naive_gemm(stream, (bf16*)(ws + WS_MN), DM, (bf16*)(ws + WS_WT_XKV), DM, 0, 1 << 30, BATCH * MEML, 2 * DM, DM, NM_BF16, KV, 2 * DM, 1.f); break;
        case PH_FOLD:
            for (int b = 0; b < BATCH; ++b) for (int h = 0; h < XH; ++h) {
                launch_naive_gemm(stream, KV + (size_t)b * MEML * 2 * DM + h * XHD, 2 * DM, (bf16*)(ws + WS_WN_XQ) + h * XHD, DM, 0, 1 << 30, MEML, DM, XHD, NM_BF16, WQK + ((size_t)b * DM + h * MEML) * DM, DM, XSC);
                launch_naive_gemm(stream, (bf16*)(ws + WS_WT_XO) + h * XHD, DM, KV + (size_t)b * MEML * 2 * DM + DM + h * XHD, 2 * DM, 0, 1 << 30, DM, MEML, XHD, NM_BF16, WVO + (size_t)b * DM * DM + h * MEML, DM, 1.f);
            } break;
        case PH_INPROJ: launch_naive_gemm(stream, XN, DM, (bf16*)(ws + WS_WT_IN), DM, 0, 1 << 30, M, INC, DM, NM_INPROJ, Z, INC, 1.f);
            hipLaunchKernelGGL(naive_ksum, dim3(64 * 512 / 256), dim3(256), 0, stream, Z, KS); break;
        case PH_MIXER:
            hipLaunchKernelGGL(naive_gmlp_ln, dim3(M), dim3(64), 0, stream, Z, ((const float*)d_in[4] + (size_t)l * AW), ((const float*)d_in[5] + (size_t)l * AW), T);
            hipLaunchKernelGGL(naive_gmlp_gate, dim3(M), dim3(256), 0, stream, Z, T, ((const float*)d_in[6] + (size_t)l * AH * CHUNK * CHUNK), ((const float*)d_in[7] + (size_t)l * AH * CHUNK), Y);
            hipLaunchKernelGGL(naive_moba, dim3(M * BH), dim3(64), 0, stream, Z, KS, Y);
            hipLaunchKernelGGL(naive_conv, dim3(M * CG), dim3(64), 0, stream, Z, ((const float*)d_in[8] + (size_t)l * CONVW * CW), ((const float*)d_in[9] + (size_t)l * CW), ((const float*)d_in[10] + (size_t)l * CW), ((const float*)d_in[11] + (size_t)l * CW), Y);
            break;
        case PH_OUTPROJ: launch_naive_gemm(stream, Y, DM, (bf16*)(ws + WS_WT_OUT), DM, 0, 1 << 30, M, DM, DM, NM_F32, T, DM, 1.f); break;
        case PH_SGEMM: launch_naive_gemm(stream, XN, DM, WQK, DM, (size_t)DM * DM, SEQ, M, DM, DM, NM_F32, T, DM, 1.f);
            hipLaunchKernelGGL(naive_softmax, dim3(M * XH), dim3(64), 0, stream, T, P); break;
        case PH_PVOUT: launch_naive_gemm(stream, P, DM, WVO, DM, (size_t)DM * DM, SEQ, M, DM, DM, NM_F32, T, DM, 1.f); break;
        case PH_FF1: launch_naive_gemm(stream, XN, DM, (bf16*)(ws + WS_WT_FF1), DM, 0, 1 << 30, M, DFF, DM, NM_RELU2, H, DFF, 1.f); break;
        case PH_FF2: launch_naive_gemm(stream, H, DFF, (bf16*)(ws + WS_WT_FF2), DFF, 0, 1 << 30, M, DM, DFF, NM_F32, T, DM, 1.f); break;
        default: break;
        }
    }
}
```
